# Optimizing an MI355X kernel written in HIP

```python
import jax, jax.numpy as jnp
from jax import lax
import numpy as np

D_MODEL = 1024
BATCH = 8
SEQ = 2048
DEPTH = 1

N_HEADS = 8
N_KV = 2
GQ = N_HEADS // N_KV
HD = 64
Q_WIDTH = N_HEADS * HD
KV_WIDTH = N_KV * HD
WINDOW = 128
BLK = 128
N_FGROUPS = 4
FG_DIM = 128
F_WIDTH = N_FGROUPS * FG_DIM
N_BUCKETS = 32
MAX_DIST = 128
D_FF = 2816
EPS = 1e-6
NEG = -1e30
IN_WIDTH = Q_WIDTH + 2 * KV_WIDTH + F_WIDTH + 2 * D_MODEL

kernel_name = "hybrid_window_gqa_fnet_gated_macaron"


def _rms(x, g):
    xf = x.astype(jnp.float32)
    y = xf * lax.rsqrt(jnp.mean(xf * xf, axis=-1, keepdims=True) + EPS)
    return (y * g.astype(jnp.float32)).astype(x.dtype)


def _swiglu(h, w_up, w_down):
    gate, up = jnp.split(h @ w_up, 2, axis=-1)
    return (jax.nn.silu(gate) * up) @ w_down


def _t5_bucket_and_rel():
    rel = (np.arange(3 * BLK)[None, :] - BLK) - np.arange(BLK)[:, None]
    half = N_BUCKETS // 2
    max_exact = half // 2
    ret = (rel > 0).astype(np.int32) * half
    n = np.abs(rel)
    n_safe = np.maximum(n, 1).astype(np.float32)
    large = max_exact + (np.log(n_safe / max_exact) / np.log(MAX_DIST / max_exact)
                         * (half - max_exact)).astype(np.int32)
    large = np.minimum(large, half - 1)
    bucket = ret + np.where(n < max_exact, n, large)
    return rel, bucket.astype(np.int32)


def _window_attention(q, k, v, sink, rel_bias):
    B, S = q.shape[0], q.shape[1]
    nb = S // BLK
    qb = q.reshape(B, nb, BLK, N_KV, GQ, HD).astype(jnp.float32)
    pad = ((0, 0), (BLK, BLK), (0, 0))
    kp = jnp.pad(k, pad).reshape(B, nb + 2, BLK, N_KV, HD)
    vp = jnp.pad(v, pad).reshape(B, nb + 2, BLK, N_KV, HD)

    def win(t):
        return jnp.concatenate([t[:, :-2], t[:, 1:-1], t[:, 2:]], axis=2).astype(jnp.float32)

    kw, vw = win(kp), win(vp)
    s = jnp.einsum('bnqkgd,bnjkd->bnkgqj', qb, kw) * (HD ** -0.5)

    rel, bucket = _t5_bucket_and_rel()
    bias = rel_bias.astype(jnp.float32)[bucket]
    bias = jnp.transpose(bias, (2, 0, 1)).reshape(N_KV, GQ, BLK, 3 * BLK)
    key_idx = np.arange(nb)[:, None] * BLK - BLK + np.arange(3 * BLK)[None, :]
    mask = (np.abs(rel) <= WINDOW)[None] & ((key_idx >= 0) & (key_idx < S))[:, None, :]
    mask = jnp.asarray(mask)[None, :, None, None]
    s = jnp.where(mask, s + bias, NEG)

    sk = sink.astype(jnp.float32).reshape(1, 1, N_KV, GQ, 1, 1)
    m = jnp.maximum(s.max(axis=-1, keepdims=True), sk)
    p = jnp.exp(s - m)
    w = p / (p.sum(axis=-1, keepdims=True) + jnp.exp(sk - m))
    o = jnp.einsum('bnkgqj,bnjkd->bnqkgd', w, vw)
    return o.reshape(B, S, Q_WIDTH).astype(q.dtype)


def _fourier_mix(f):
    B, S = f.shape[0], f.shape[1]
    fg = f.astype(jnp.float32).reshape(B, S, N_FGROUPS, FG_DIM)
    y = jnp.fft.fft2(fg, axes=(1, 3), norm="ortho").real
    return y.reshape(B, S, F_WIDTH).astype(f.dtype)


def setup_inputs(seed: int = 0) -> dict:
    key = jax.random.key(seed)
    ks = jax.random.split(key, 20)
    f32 = jnp.float32

    def w(k, shape, fan_in):
        return jax.random.normal(k, shape, f32) * (fan_in ** -0.5)

    def gain(k, shape):
        return 1.0 + 0.02 * jax.random.normal(k, shape, f32)

    return {
        "x": jax.random.normal(ks[0], (BATCH, SEQ, D_MODEL), f32),
        "g_ffn1": gain(ks[1], (DEPTH, D_MODEL)),
        "w_up1": w(ks[2], (DEPTH, D_MODEL, 2 * D_FF), D_MODEL),
        "w_down1": w(ks[3], (DEPTH, D_FF, D_MODEL), D_FF),
        "g_mix": gain(ks[4], (DEPTH, D_MODEL)),
        "w_in": w(ks[5], (DEPTH, D_MODEL, IN_WIDTH), D_MODEL),
        "b_gate": 0.01 * jax.random.normal(ks[6], (DEPTH, 2 * D_MODEL), f32),
        "sink": 0.5 * jax.random.normal(ks[7], (DEPTH, N_HEADS), f32),
        "rel_bias": 0.5 * jax.random.normal(ks[8], (N_BUCKETS, N_HEADS), f32),
        "w_branch_a": w(ks[9], (DEPTH, Q_WIDTH, D_MODEL), Q_WIDTH),
        "w_branch_b": w(ks[10], (DEPTH, F_WIDTH, D_MODEL), F_WIDTH),
        "w_out": w(ks[11], (DEPTH, D_MODEL, D_MODEL), D_MODEL),
        "g_ffn2": gain(ks[12], (DEPTH, D_MODEL)),
        "w_up2": w(ks[13], (DEPTH, D_MODEL, 2 * D_FF), D_MODEL),
        "w_down2": w(ks[14], (DEPTH, D_FF, D_MODEL), D_FF),
        "g_final": gain(ks[15], (D_MODEL,)),
    }


def reference(x, g_ffn1, w_up1, w_down1, g_mix, w_in, b_gate, sink, rel_bias,
              w_branch_a, w_branch_b, w_out, g_ffn2, w_up2, w_down2, g_final):
    o_q = Q_WIDTH
    o_k = o_q + KV_WIDTH
    o_v = o_k + KV_WIDTH
    o_f = o_v + F_WIDTH
    for l in range(DEPTH):
        x = x + 0.5 * _swiglu(_rms(x, g_ffn1[l]), w_up1[l], w_down1[l])
        h = _rms(x, g_mix[l])
        z = h @ w_in[l]
        q, k, v = z[..., :o_q], z[..., o_q:o_k], z[..., o_k:o_v]
        f = z[..., o_v:o_f]
        gates = jax.nn.sigmoid(z[..., o_f:] + b_gate[l])
        gate_a, gate_b = gates[..., :D_MODEL], gates[..., D_MODEL:]
        y_a = _window_attention(q, k, v, sink[l], rel_bias) @ w_branch_a[l]
        y_b = _fourier_mix(f) @ w_branch_b[l]
        x = x + (gate_a * y_a + gate_b * y_b) @ w_out[l]
        x = x + 0.5 * _swiglu(_rms(x, g_ffn2[l]), w_up2[l], w_down2[l])
    return _rms(x, g_final)
```

```cpp
#include <hip/hip_runtime.h>
#include <cstdio>
#include <cstdint>
#include <cmath>

#define LAS __attribute__((address_space(3)))
#define GAS __attribute__((address_space(1)))
typedef unsigned short bf16_t;
typedef short bf16x8 __attribute__((ext_vector_type(8)));
typedef float f32x4 __attribute__((ext_vector_type(4)));
typedef float f32x16 __attribute__((ext_vector_type(16)));
typedef unsigned u32x4 __attribute__((ext_vector_type(4)));
typedef float f32x2_t __attribute__((ext_vector_type(2)));
typedef __bf16 bf16x2_t __attribute__((ext_vector_type(2)));
typedef short s16x4 __attribute__((ext_vector_type(4)));

constexpr int DM = 1024, NB = 8, SEQ = 2048, MTOK = NB * SEQ, DFF = 2816, NUP = 2 * DFF, INW = 3328;
constexpr int KAB = 1536;
constexpr float LOG2E = 1.4426950408889634f;
constexpr float QSCALE = 0.125f * LOG2E;
constexpr float RMS_EPS = 1e-6f;
constexpr size_t SLAB = (size_t)23 << 20, SLAB_E = SLAB / 2;
__device__ __forceinline__ unsigned short* brow(unsigned short* base, int row, int pitch) { return base + (size_t)(row >> 11) * SLAB_E + (size_t)(row & 2047) * pitch; }
__device__ __forceinline__ const unsigned short* brow(const unsigned short* base, int row, int pitch) { return base + (size_t)(row >> 11) * SLAB_E + (size_t)(row & 2047) * pitch; }

__device__ __forceinline__ unsigned cvtpk(float lo, float hi) { f32x2_t v = {lo, hi}; bf16x2_t b = __builtin_convertvector(v, bf16x2_t); return __builtin_bit_cast(unsigned, b); }
__device__ __forceinline__ u32x4 pack8(f32x4 a, f32x4 b) { u32x4 w; w.x = cvtpk(a[0], a[1]); w.y = cvtpk(a[2], a[3]); w.z = cvtpk(b[0], b[1]); w.w = cvtpk(b[2], b[3]); return w; }
#ifndef WT_STORES
#define WT_STORES 0
#endif
__device__ __forceinline__ void st16(void* p, u32x4 v) {
#if WT_STORES
    asm volatile("global_store_dwordx4 %0, %1, off sc1\n\ts_nop 1" :: "v"(p), "v"(v) : "memory");
#else
    *(u32x4*)p = v;
#endif
}
__device__ __forceinline__ void st16f(void* p, f32x4 v) { st16(p, __builtin_bit_cast(u32x4, v)); }
__device__ __forceinline__ float bf2f(unsigned short h) { return __builtin_bit_cast(float, (unsigned)h << 16); }
__device__ __forceinline__ float row_rinv(const float* RS, int row) { const f32x4 p = *(const f32x4*)(RS + 4 * (size_t)row); return rsqrtf(((p[0] + p[1]) + (p[2] + p[3])) * (1.0f / DM) + RMS_EPS); }

namespace pg8 {
constexpr int BM = 256, BK = 64, HALF = 128, HTB = HALF * BK * 2, STAGE_BYTES = 8 * HTB, NXCD = 8, WGM = 8;
__host__ __device__ __forceinline__ int lds_byte(int r, int c) { const int st = (r >> 4) * 2 + (c >> 5), rr = r & 15, cc = c & 31, ob = rr * 64 + cc * 2; return st * 1024 + (ob ^ (((ob >> 9) & 1) << 5)); }
__host__ __device__ __forceinline__ void stage_rc(int b, int& R, int& C) { const int st = b / 1024, sb = b % 1024, swz = sb ^ (((sb >> 9) & 1) << 5); R = (st >> 1) * 16 + swz / 64; C = (st & 1) * 32 + (swz % 64) / 2; }
__host__ __device__ __forceinline__ int perm32(int rho) { const int n = rho >> 4, i = rho & 15; return 8 * (i >> 2) + 4 * n + (i & 3); }

struct Unit { int pm, pn; };
struct GemmP { int K, lda, ldb; };

struct TileOrder {
    int nM, nN, nwg, G, c;
    __device__ void init(int M, int N, int G_, int c_) { nM = M / BM; nN = N / BM; nwg = nM * nN; G = G_; c = c_; }
    __device__ bool tile(int i, Unit& u) const {
        const long L = (long)i * G + c; if (L >= nwg) return false;
        int wgid = (int)L; { const int q = nwg / NXCD, r = nwg % NXCD, xcd = wgid % NXCD, off = wgid / NXCD; wgid = (xcd < r ? xcd * (q + 1) : r * (q + 1) + (xcd - r) * q) + off; }
        const int nig = WGM * nN, gid = wgid / nig, fm = gid * WGM, gsz = (nM - fm) < WGM ? (nM - fm) : WGM;
        u.pm = fm + ((wgid % nig) % gsz); u.pn = (wgid % nig) / gsz; return true;
    }
};

template <class Epi, class Sched, bool ALIGN_EPI>
__device__ __forceinline__ void gemm_phase(LAS unsigned char* lds, const GemmP g, const Sched& S, const Epi& E) {
    int tid = threadIdx.x; asm volatile("" : "+v"(tid));
    const int wid = __builtin_amdgcn_readfirstlane(tid >> 6), lane = tid & 63, wr = wid >> 2, wc = wid & 3, fr = lane & 15, fq = lane >> 4;
    const int K = g.K, nt = K / BK;
    unsigned voffA[2], voffB[2];
#pragma unroll
    for (int i = 0; i < 2; ++i) { int R, C; stage_rc(tid * 16 + i * 8192, R, C); const int Rb = (R & ~31) + perm32(R & 31);
        voffA[i] = (unsigned)(R * g.lda + C) * 2u; voffB[i] = (unsigned)(Rb * g.ldb + C) * 2u; }
    const size_t kstep = (size_t)(BK * 2);
    const size_t hstepA = (size_t)HALF * g.lda * 2, hstepB = (size_t)HALF * g.ldb * 2;
    const unsigned ldsw = (unsigned)wid * 1024u;
    const int aoff = lds_byte(wr * 64 + fr, fq * 8), boff = lds_byte(wc * 32 + fr, fq * 8);
#define PG8_SA(b, h) (((b) * 2 + (h)) * HTB)
#define PG8_SB(b, h) ((4 + (b) * 2 + (h)) * HTB)
#define PG8_STAGE(bufoff, gbase, voff) do { _Pragma("unroll") for (int _i = 0; _i < 2; ++_i) \
        __builtin_amdgcn_global_load_lds((const unsigned*)((const char*)(gbase) + (voff)[_i]), (LAS unsigned*)(lds + (bufoff) + ldsw + _i * 8192), 16, 0, 0); } while (0)
#define PG8_LDA(dst, b, h) do { _Pragma("unroll") for (int m = 0; m < 4; ++m) _Pragma("unroll") for (int k = 0; k < 2; ++k) dst[m][k] = *(const LAS bf16x8*)(lds + PG8_SA(b, h) + aoff + m * 2048 + k * 1024); } while (0)
#define PG8_LDB(dst, b, h) do { _Pragma("unroll") for (int n = 0; n < 2; ++n) _Pragma("unroll") for (int k = 0; k < 2; ++k) dst[n][k] = *(const LAS bf16x8*)(lds + PG8_SB(b, h) + boff + n * 2048 + k * 1024); } while (0)
#define PG8_MMA(ai, bj, At, Bt) do { __builtin_amdgcn_s_setprio(1); _Pragma("unroll") for (int m = 0; m < 4; ++m) _Pragma("unroll") for (int n = 0; n < 2; ++n) _Pragma("unroll") for (int k = 0; k < 2; ++k) \
        acc[ai][bj][m][n] = __builtin_amdgcn_mfma_f32_16x16x32_bf16(Bt[n][k], At[m][k], acc[ai][bj][m][n], 0, 0, 0); __builtin_amdgcn_s_setprio(0); } while (0)
#define PG8_WAIT_V(n) asm volatile("s_waitcnt vmcnt(" #n ")" ::: "memory")
#define PG8_WAIT_L(n) asm volatile("s_waitcnt lgkmcnt(" #n ")" ::: "memory")
#define PG8_BAR __builtin_amdgcn_s_barrier()
#define PG8_SCHED __builtin_amdgcn_sched_barrier(0)
    Unit cur, nxt; int ui = 0;
    if (!S.next(0, cur)) return;
    f32x4 acc[2][2][4][2];
#pragma unroll
    for (int a = 0; a < 2; ++a)
#pragma unroll
        for (int b = 0; b < 2; ++b)
#pragma unroll
            for (int m = 0; m < 4; ++m)
#pragma unroll
                for (int n = 0; n < 2; ++n) acc[a][b][m][n] = (f32x4){0.f, 0.f, 0.f, 0.f};
    bf16x8 At[4][2], B0[2][2], B1[2][2];
    const char* cA = S.opA(cur); const char* cB = S.opB(cur);
    PG8_STAGE(PG8_SB(0, 0), cB, voffB); PG8_STAGE(PG8_SB(0, 1), cB + hstepB, voffB); PG8_STAGE(PG8_SA(0, 0), cA, voffA); PG8_STAGE(PG8_SA(0, 1), cA + hstepA, voffA);
    if (wr == 1) PG8_BAR;
    PG8_WAIT_V(2); PG8_BAR;
    PG8_STAGE(PG8_SB(1, 0), cB + kstep, voffB); PG8_STAGE(PG8_SA(1, 0), cA + kstep, voffA); PG8_STAGE(PG8_SB(1, 1), cB + hstepB + kstep, voffB);
    PG8_WAIT_V(6); PG8_BAR;
    for (;;) {
        const bool has_next = S.next(ui + 1, nxt);
        const char* nA = has_next ? S.opA(nxt) : cA; const char* nB = has_next ? S.opB(nxt) : cB;
        for (int t = 0; t < nt; t += 2) {
            const bool last = (t == nt - 2);
            const char* a1 = cA + (size_t)(t + 1) * kstep;
            const char* a2 = last ? nA : cA + (size_t)(t + 2) * kstep; const char* b2 = last ? nB : cB + (size_t)(t + 2) * kstep;
            const char* a3 = a2 + kstep; const char* b3 = b2 + kstep;
            if constexpr (Epi::MID_T >= 0) { if (t == Epi::MID_T) E.mid(acc, cur, wr, wc, fr, fq); }
            PG8_LDB(B0, 0, 0); PG8_LDB(B1, 0, 1); PG8_SCHED; PG8_LDA(At, 0, 0); PG8_STAGE(PG8_SA(1, 1), a1 + hstepA, voffA);
            PG8_WAIT_V(8); PG8_WAIT_L(0); PG8_BAR; PG8_MMA(0, 0, At, B0); PG8_MMA(0, 1, At, B1); PG8_BAR; PG8_SCHED;
            PG8_LDA(At, 0, 1); PG8_STAGE(PG8_SB(0, 0), b2, voffB); PG8_STAGE(PG8_SB(0, 1), b2 + hstepB, voffB); PG8_STAGE(PG8_SA(0, 0), a2, voffA);
            PG8_WAIT_V(8); PG8_WAIT_L(0); PG8_BAR; PG8_MMA(1, 0, At, B0); PG8_MMA(1, 1, At, B1); PG8_BAR; PG8_SCHED;
            PG8_LDB(B0, 1, 0); PG8_LDB(B1, 1, 1); PG8_SCHED; PG8_LDA(At, 1, 0); PG8_STAGE(PG8_SA(0, 1), a2 + hstepA, voffA);
            PG8_WAIT_V(8); PG8_WAIT_L(0); PG8_BAR; PG8_MMA(0, 0, At, B0); PG8_MMA(0, 1, At, B1); PG8_BAR; PG8_SCHED;
            PG8_LDA(At, 1, 1); PG8_STAGE(PG8_SB(1, 0), b3, voffB); PG8_STAGE(PG8_SB(1, 1), b3 + hstepB, voffB); PG8_STAGE(PG8_SA(1, 0), a3, voffA);
            PG8_WAIT_V(8); PG8_WAIT_L(0); PG8_BAR; PG8_MMA(1, 0, At, B0); PG8_MMA(1, 1, At, B1); PG8_BAR; PG8_SCHED;
        }
        if constexpr (ALIGN_EPI) { if (wr == 0) PG8_BAR; }
        if constexpr (!Epi::AFTER_DRAIN) { E(acc, cur, wr, wc, fr, fq); }
        if (!has_next) break;
#pragma unroll
        for (int a = 0; a < 2; ++a)
#pragma unroll
            for (int b = 0; b < 2; ++b)
#pragma unroll
                for (int m = 0; m < 4; ++m)
#pragma unroll
                    for (int n = 0; n < 2; ++n) acc[a][b][m][n] = (f32x4){0.f, 0.f, 0.f, 0.f};
        cur = nxt; cA = nA; cB = nB; ++ui;
        if constexpr (ALIGN_EPI) { if (wr == 1) PG8_BAR; }
    }
    PG8_WAIT_V(0);
    if constexpr (!ALIGN_EPI) { if (wr == 0) PG8_BAR; }
    PG8_BAR;
    if constexpr (Epi::AFTER_DRAIN) { E.fused(acc, cur, wr, wc, fr, fq, lds, wid, lane); }
#undef PG8_SA
#undef PG8_SB
#undef PG8_STAGE
#undef PG8_LDA
#undef PG8_LDB
#undef PG8_MMA
#undef PG8_WAIT_V
#undef PG8_WAIT_L
#undef PG8_BAR
#undef PG8_SCHED
}
}
using pg8::Unit;
typedef f32x4 Acc[2][2][4][2];

struct SchedPlain {
    pg8::TileOrder T; const char* A; const char* Bt; size_t tA, tB;
    __device__ __forceinline__ bool next(int i, Unit& u) const { return T.tile(i, u); }
    __device__ __forceinline__ const char* opA(const Unit& u) const { return A + (size_t)(u.pm >> 3) * SLAB + (size_t)(u.pm & 7) * tA; }
    __device__ __forceinline__ const char* opB(const Unit& u) const { return Bt + (size_t)u.pn * tB; }
};
struct SchedWin {
    pg8::TileOrder T; const char* X; const char* W; size_t tX, tW;
    __device__ __forceinline__ bool next(int i, Unit& u) const { return T.tile(i, u); }
    __device__ __forceinline__ const char* xp(const Unit& u) const { return X + (size_t)(u.pm >> 3) * SLAB + (size_t)(u.pm & 7) * tX; }
    __device__ __forceinline__ const char* opA(const Unit& u) const { return (u.pn == 3 || u.pn == 4) ? W + (size_t)u.pn * tW : xp(u); }
    __device__ __forceinline__ const char* opB(const Unit& u) const { return (u.pn == 3 || u.pn == 4) ? xp(u) : W + (size_t)u.pn * tW; }
};
struct SchedOne {
    const char* A; const char* Bt; Unit u0;
    __device__ __forceinline__ bool next(int i, Unit& u) const { if (i > 0) return false; u = u0; return true; }
    __device__ __forceinline__ const char* opA(const Unit&) const { return A; }
    __device__ __forceinline__ const char* opB(const Unit&) const { return Bt; }
};

struct EpiSwiGLU {
    static constexpr bool AFTER_DRAIN = false; static constexpr int MID_T = -1;
    const float* RS; bf16_t* O;
    __device__ __forceinline__ void mid(Acc&, const Unit&, int, int, int, int) const {}
    __device__ __forceinline__ void operator()(const Acc& acc, const Unit& u, int wr, int wc, int fr, int fq) const {
        asm volatile("" : "+v"(fr), "+v"(fq));
        const int row0 = u.pm * 256 + wr * 64 + fr, col0 = u.pn * 128 + wc * 32 + 8 * fq;
#pragma unroll
        for (int ai = 0; ai < 2; ++ai)
#pragma unroll
            for (int m = 0; m < 4; ++m) {
                const int row = row0 + ai * 128 + m * 16; const float r = row_rinv(RS, row);
                f32x4 o[2];
#pragma unroll
                for (int n = 0; n < 2; ++n) { const f32x4 g = acc[ai][0][m][n] * r, up = acc[ai][1][m][n] * r;
#pragma unroll
                    for (int j = 0; j < 4; ++j) { const float e = __builtin_amdgcn_exp2f(-g[j] * LOG2E); o[n][j] = g[j] * up[j] * __builtin_amdgcn_rcpf(1.0f + e); } }
                st16(brow(O, row, DFF) + col0, pack8(o[0], o[1]));
            }
    }
};
struct EpiResid {
    static constexpr bool AFTER_DRAIN = true; static constexpr int MID_T = -1;
    const float* xin; float* xout; bf16_t* XB; float* RSo; float alpha;
    __device__ __forceinline__ void mid(Acc&, const Unit&, int, int, int, int) const {}
    __device__ __forceinline__ void operator()(const Acc&, const Unit&, int, int, int, int) const {}
    __device__ __forceinline__ void fused(Acc& acc, const Unit& u, int wr, int wc, int fr, int fq, LAS unsigned char* lds, int wid, int lane) const {
        asm volatile("" : "+v"(fr), "+v"(fq));
        LAS float* P = (LAS float*)lds;
#pragma unroll
        for (int ai = 0; ai < 2; ++ai)
#pragma unroll
            for (int m = 0; m < 4; ++m) {
                const int rl = ai * 128 + wr * 64 + m * 16 + fr, row = u.pm * 256 + rl; float ss = 0.f;
#pragma unroll
                for (int bj = 0; bj < 2; ++bj) {
                    const size_t off = (size_t)row * DM + u.pn * 256 + bj * 128 + wc * 32 + 8 * fq;
                    f32x4 x0 = *(const f32x4*)(xin + off), x1 = *(const f32x4*)(xin + off + 4);
                    x0 = x0 + acc[ai][bj][m][0] * alpha; x1 = x1 + acc[ai][bj][m][1] * alpha;
                    st16f(xout + off, x0); st16f(xout + off + 4, x1);
                    ss += (x0[0] * x0[0] + x0[1] * x0[1]) + (x0[2] * x0[2] + x0[3] * x0[3]) + (x1[0] * x1[0] + x1[1] * x1[1]) + (x1[2] * x1[2] + x1[3] * x1[3]);
                    if (XB) st16(brow(XB, row, DM) + u.pn * 256 + bj * 128 + wc * 32 + 8 * fq, pack8(x0, x1));
                }
                ss += __shfl_xor(ss, 16); ss += __shfl_xor(ss, 32);
                if (fq == 0) P[rl * 4 + wc] = ss;
            }
        asm volatile("s_waitcnt lgkmcnt(0)" ::: "memory"); __builtin_amdgcn_s_barrier(); asm volatile("" ::: "memory");
        const int tid = wid * 64 + lane;
        if (tid < 256) { const f32x4 p = *(const LAS f32x4*)(P + tid * 4); RSo[(size_t)(u.pm * 256 + tid) * 4 + u.pn] = (p[0] + p[1]) + (p[2] + p[3]); }
    }
};
struct EpiWin {
    static constexpr bool AFTER_DRAIN = false; static constexpr int MID_T = -1;
    const float* RS; const float* bg; bf16_t* QKV; bf16_t* FT; bf16_t* GATES;
    __device__ __forceinline__ void mid(Acc&, const Unit&, int, int, int, int) const {}
    __device__ __forceinline__ void operator()(const Acc& acc, const Unit& u, int wr, int wc, int fr, int fq) const {
        asm volatile("" : "+v"(fr), "+v"(fq));
        if (u.pn < 3) {
            const int row0 = u.pm * 256 + wr * 64 + fr, col0 = u.pn * 256 + wc * 32 + 8 * fq;
#pragma unroll
            for (int ai = 0; ai < 2; ++ai)
#pragma unroll
                for (int m = 0; m < 4; ++m) { const int row = row0 + ai * 128 + m * 16; const float r = row_rinv(RS, row);
#pragma unroll
                    for (int bj = 0; bj < 2; ++bj) st16(brow(QKV, row, 768) + col0 + bj * 128, pack8(acc[ai][bj][m][0] * r, acc[ai][bj][m][1] * r)); }
        } else if (u.pn < 5) {
            f32x4 rt[2][2];
#pragma unroll
            for (int bj = 0; bj < 2; ++bj)
#pragma unroll
                for (int n = 0; n < 2; ++n)
#pragma unroll
                    for (int j = 0; j < 4; ++j) rt[bj][n][j] = row_rinv(RS, u.pm * 256 + bj * 128 + wc * 32 + 8 * fq + 4 * n + j);
            const int b = u.pm >> 3, s0 = (u.pm & 7) * 256 + wc * 32 + 8 * fq;
#pragma unroll
            for (int ai = 0; ai < 2; ++ai)
#pragma unroll
                for (int m = 0; m < 4; ++m) { const int ch = (u.pn - 3) * 256 + ai * 128 + wr * 64 + m * 16 + fr; bf16_t* base = FT + (size_t)b * SLAB_E + (size_t)ch * SEQ + s0;
#pragma unroll
                    for (int bj = 0; bj < 2; ++bj) st16(base + bj * 128, pack8(acc[ai][bj][m][0] * rt[bj][0], acc[ai][bj][m][1] * rt[bj][1])); }
        } else {
            const int c0 = (u.pn - 5) * 128 + wc * 32 + 8 * fq, row0 = u.pm * 256 + wr * 64 + fr;
            f32x4 ba[2], bb[2];
#pragma unroll
            for (int n = 0; n < 2; ++n) { ba[n] = *(const f32x4*)(bg + c0 + 4 * n); bb[n] = *(const f32x4*)(bg + DM + c0 + 4 * n); }
#pragma unroll
            for (int ai = 0; ai < 2; ++ai)
#pragma unroll
                for (int m = 0; m < 4; ++m) { const int row = row0 + ai * 128 + m * 16; const float r = row_rinv(RS, row);
                    f32x4 ra[2], gb[2];
#pragma unroll
                    for (int n = 0; n < 2; ++n) { const f32x4 za = acc[ai][0][m][n] * r + ba[n], zb = acc[ai][1][m][n] * r + bb[n];
#pragma unroll
                        for (int j = 0; j < 4; ++j) { const float ea = __builtin_amdgcn_exp2f(-za[j] * LOG2E), eb = __builtin_amdgcn_exp2f(-zb[j] * LOG2E);
                            ra[n][j] = (1.0f + eb) * __builtin_amdgcn_rcpf(1.0f + ea); gb[n][j] = __builtin_amdgcn_rcpf(1.0f + eb); } }
                    bf16_t* gp = brow(GATES, row, 2048) + c0; st16(gp, pack8(ra[0], ra[1])); st16(gp + DM, pack8(gb[0], gb[1])); }
        }
    }
};
struct EpiDft {
    static constexpr bool AFTER_DRAIN = false; static constexpr int MID_T = -1;
    bf16_t* AOPQ; int b;
    __device__ __forceinline__ void mid(Acc&, const Unit&, int, int, int, int) const {}
    __device__ __forceinline__ void operator()(const Acc& acc, const Unit& u, int wr, int wc, int fr, int fq) const {
        asm volatile("" : "+v"(fr), "+v"(fq));
        const int part = u.pm >> 3, k0 = (u.pm & 7) * 256 + wr * 64 + fr;
#pragma unroll
        for (int ai = 0; ai < 2; ++ai)
#pragma unroll
            for (int m = 0; m < 4; ++m) { const int k = k0 + ai * 128 + m * 16; bf16_t* base = AOPQ + (size_t)b * SLAB_E + (size_t)k * KAB + 512 + part * 128 + wc * 32 + 8 * fq;
#pragma unroll
                for (int bj = 0; bj < 2; ++bj) st16(base + (u.pn * 2 + bj) * 256, pack8(acc[ai][bj][m][0], acc[ai][bj][m][1])); }
    }
};
struct EpiGate {
    static constexpr bool AFTER_DRAIN = false; static constexpr int MID_T = 8;
    bf16_t* GATES;
    __device__ __forceinline__ void scale(Acc& acc, const Unit& u, int wr, int wc, int fr, int fq, int goff) const {
        asm volatile("" : "+v"(fr), "+v"(fq));
#pragma unroll
        for (int ai = 0; ai < 2; ++ai)
#pragma unroll
            for (int m = 0; m < 4; ++m) { const int row = u.pm * 256 + ai * 128 + wr * 64 + m * 16 + fr;
#pragma unroll
                for (int bj = 0; bj < 2; ++bj) { const u32x4 w = *(const u32x4*)(brow(GATES, row, 2048) + goff + u.pn * 256 + bj * 128 + wc * 32 + 8 * fq);
                    f32x4 s0, s1; s0[0] = __builtin_bit_cast(float, w.x << 16); s0[1] = __builtin_bit_cast(float, w.x & 0xffff0000u); s0[2] = __builtin_bit_cast(float, w.y << 16); s0[3] = __builtin_bit_cast(float, w.y & 0xffff0000u);
                    s1[0] = __builtin_bit_cast(float, w.z << 16); s1[1] = __builtin_bit_cast(float, w.z & 0xffff0000u); s1[2] = __builtin_bit_cast(float, w.w << 16); s1[3] = __builtin_bit_cast(float, w.w & 0xffff0000u);
                    acc[ai][bj][m][0] = acc[ai][bj][m][0] * s0; acc[ai][bj][m][1] = acc[ai][bj][m][1] * s1; }
                asm volatile("" : "+v"(acc[ai][0][m][0]), "+v"(acc[ai][0][m][1]), "+v"(acc[ai][1][m][0]), "+v"(acc[ai][1][m][1]));
                if (m & 1) asm volatile("" ::: "memory"); }
    }
    __device__ __forceinline__ void mid(Acc& acc, const Unit& u, int wr, int wc, int fr, int fq) const { scale(acc, u, wr, wc, fr, fq, 0); }
    __device__ __forceinline__ void operator()(Acc& acc, const Unit& u, int wr, int wc, int fr, int fq) const {
        scale(acc, u, wr, wc, fr, fq, DM);
#pragma unroll
        for (int ai = 0; ai < 2; ++ai)
#pragma unroll
            for (int m = 0; m < 4; ++m) { const int row = u.pm * 256 + ai * 128 + wr * 64 + m * 16 + fr;
#pragma unroll
                for (int bj = 0; bj < 2; ++bj) st16(brow(GATES, row, 2048) + u.pn * 256 + bj * 128 + wc * 32 + 8 * fq, pack8(acc[ai][bj][m][0], acc[ai][bj][m][1])); }
    }
};

namespace att {
constexpr int LDS_K = 0, LDS_V = 49152, LDS_OST = 98304;
__device__ __forceinline__ int crow(int r, int hi) { return (r & 3) + 8 * (r >> 2) + 4 * hi; }
__device__ __forceinline__ int t5_bucket(int rel) {
    const int n = rel < 0 ? -rel : rel; int b;
    if (n < 8) b = n; else if (n < 12) b = 8; else if (n < 16) b = 9; else if (n < 23) b = 10; else if (n < 32) b = 11; else if (n < 46) b = 12; else if (n < 64) b = 13; else if (n < 91) b = 14; else b = 15;
    return b + (rel > 0 ? 16 : 0);
}
__device__ __forceinline__ s16x4 vtr(const LAS unsigned char* p) { typedef short v4i16_t __attribute__((ext_vector_type(4))); return __builtin_bit_cast(s16x4, __builtin_amdgcn_ds_read_tr16_b64_v4i16((LAS v4i16_t*)p)); }
__device__ __forceinline__ unsigned short f2bf(float f) { unsigned u = __builtin_bit_cast(unsigned, f); return (unsigned short)((u + 0x7fffu + ((u >> 16) & 1u)) >> 16); }

__device__ __forceinline__ void attn_unit(LAS unsigned char* ring, LAS float* biasT  , LAS float* wsfAll  , const bf16_t* QKV, bf16_t* AOPQ,
                                          const float* sink, const float* relb, int b, int kvh, int n) {
    const int tid = threadIdx.x, lane = tid & 63, r32 = lane & 31, hi = lane >> 5, wid = __builtin_amdgcn_readfirstlane(tid >> 6);
    for (int t = tid; t < 4 * 257; t += 512) { const int g = t / 257, idx = t - g * 257; biasT[g * 260 + idx] = relb[t5_bucket(idx - 128) * 8 + kvh * 4 + g] * LOG2E; }
    const int tlo = (n == 0) ? 2 : 0, thi = (n == 15) ? 3 : 5;
    const size_t rowb = 0; QKV += (size_t)b * SLAB_E; AOPQ += (size_t)b * SLAB_E; const int key0 = 128 * (n - 1);
    for (int t = tlo; t <= thi; ++t) {
        const bf16_t* ks = QKV + (rowb + key0 + 64 * t + lane) * 768 + 512 + kvh * 64 + wid * 8;
        __builtin_amdgcn_global_load_lds((const unsigned*)ks, (LAS unsigned*)(ring + LDS_K + t * 8192 + wid * 1024), 16, 0, 0);
        const bf16_t* vs = QKV + (rowb + key0 + 64 * t + 16 * (wid & 3) + (lane >> 2)) * 768 + 640 + kvh * 64 + (wid >> 2) * 32 + (lane & 3) * 8;
        __builtin_amdgcn_global_load_lds((const unsigned*)vs, (LAS unsigned*)(ring + LDS_V + t * 8192 + wid * 1024), 16, 0, 0);
    }
    asm volatile("s_waitcnt vmcnt(0) lgkmcnt(0)" ::: "memory"); __builtin_amdgcn_s_barrier(); asm volatile("" ::: "memory");
    const int g = wid >> 1, h = kvh * 4 + g;
    LAS float* wsf = wsfAll + wid * 64; const LAS float* bT = biasT + g * 260;
    const float sinkl = sink[h] * LOG2E;
    for (int qq = 0; qq < 2; ++qq) {
        const int q0 = (wid & 1) * 64 + 32 * qq, qpos = 128 + q0 + r32;
        const bf16_t* qp = QKV + (rowb + 128 * n + q0 + r32) * 768 + h * 64 + hi * 8;
        bf16x8 qr[4];
#pragma unroll
        for (int d0 = 0; d0 < 4; ++d0) qr[d0] = *(const bf16x8*)(qp + d0 * 16);
        float m_run = sinkl, l_run = hi ? 0.f : 1.f;
        f32x16 o0, o1;
#pragma unroll
        for (int r = 0; r < 16; ++r) { o0[r] = 0.f; o1[r] = 0.f; }
        int t0 = q0 >> 6, t1 = (287 + q0) >> 6; t0 = t0 < tlo ? tlo : t0; t1 = t1 > thi ? thi : t1;
        for (int t = t0; t <= t1; ++t) {
            f32x16 p0, p1;
#pragma unroll
            for (int r = 0; r < 16; ++r) { p0[r] = 0.f; p1[r] = 0.f; }
            const LAS unsigned char* kb = ring + LDS_K + t * 8192 + hi * 1024 + r32 * 16;
#pragma unroll
            for (int d0 = 0; d0 < 4; ++d0) { const bf16x8 k0 = *(const LAS bf16x8*)(kb + d0 * 2048), k1 = *(const LAS bf16x8*)(kb + d0 * 2048 + 512);
                p0 = __builtin_amdgcn_mfma_f32_32x32x16_bf16(k0, qr[d0], p0, 0, 0, 0); p1 = __builtin_amdgcn_mfma_f32_32x32x16_bf16(k1, qr[d0], p1, 0, 0, 0); }
            const int base = 64 * t - qpos + 128;
            float tm = -INFINITY;
#pragma unroll
            for (int r = 0; r < 16; ++r) { const int i0 = base + crow(r, hi), i1 = i0 + 32;
                const int c0 = i0 < 0 ? 0 : (i0 > 256 ? 256 : i0), c1 = i1 < 0 ? 0 : (i1 > 256 ? 256 : i1);
                const float b0 = bT[c0], b1 = bT[c1];
                p0[r] = (i0 >= 0 && i0 <= 256) ? p0[r] + b0 : -INFINITY; p1[r] = (i1 >= 0 && i1 <= 256) ? p1[r] + b1 : -INFINITY;
                tm = fmaxf(tm, fmaxf(p0[r], p1[r])); }
            tm = fmaxf(tm, __shfl_xor(tm, 32));
            const float mn = fmaxf(m_run, tm), alpha = __builtin_amdgcn_exp2f(m_run - mn); m_run = mn;
            float rs = 0.f;
#pragma unroll
            for (int r = 0; r < 16; ++r) { p0[r] = __builtin_amdgcn_exp2f(p0[r] - mn); p1[r] = __builtin_amdgcn_exp2f(p1[r] - mn); rs += p0[r] + p1[r]; }
            l_run = l_run * alpha + rs;
            if (hi == 0) wsf[r32] = alpha;
            asm volatile("s_waitcnt lgkmcnt(0)" ::: "memory");
#pragma unroll
            for (int r = 0; r < 16; ++r) { const float a = wsf[crow(r, hi)]; o0[r] *= a; o1[r] *= a; }
            u32x4 pw[4];
            pw[0] = (u32x4){cvtpk(p0[0], p0[1]), cvtpk(p0[2], p0[3]), cvtpk(p0[4], p0[5]), cvtpk(p0[6], p0[7])};
            pw[1] = (u32x4){cvtpk(p0[8], p0[9]), cvtpk(p0[10], p0[11]), cvtpk(p0[12], p0[13]), cvtpk(p0[14], p0[15])};
            pw[2] = (u32x4){cvtpk(p1[0], p1[1]), cvtpk(p1[2], p1[3]), cvtpk(p1[4], p1[5]), cvtpk(p1[6], p1[7])};
            pw[3] = (u32x4){cvtpk(p1[8], p1[9]), cvtpk(p1[10], p1[11]), cvtpk(p1[12], p1[13]), cvtpk(p1[14], p1[15])};
            const LAS unsigned char* vb = ring + LDS_V + t * 8192 + ((lane >> 4) & 1) * 32 + (lane & 3) * 8 + (4 * hi + ((lane & 15) >> 2)) * 64;
#pragma unroll
            for (int ks = 0; ks < 4; ++ks) {
                const s16x4 l0 = vtr(vb + ks * 1024), h0 = vtr(vb + ks * 1024 + 512), l1 = vtr(vb + 4096 + ks * 1024), h1 = vtr(vb + 4096 + ks * 1024 + 512);
                const bf16x8 v0 = (bf16x8){l0[0], l0[1], l0[2], l0[3], h0[0], h0[1], h0[2], h0[3]}, v1 = (bf16x8){l1[0], l1[1], l1[2], l1[3], h1[0], h1[1], h1[2], h1[3]};
                const bf16x8 pa = __builtin_bit_cast(bf16x8, pw[ks]);
                o0 = __builtin_amdgcn_mfma_f32_32x32x16_bf16(pa, v0, o0, 0, 0, 0); o1 = __builtin_amdgcn_mfma_f32_32x32x16_bf16(pa, v1, o1, 0, 0, 0);
            }
        }
        const float lt = l_run + __shfl_xor(l_run, 32);
        if (hi == 0) wsf[32 + r32] = lt;
        asm volatile("s_waitcnt lgkmcnt(0)" ::: "memory");
        LAS unsigned short* stg = (LAS unsigned short*)(ring + LDS_OST + wid * 4096);
#pragma unroll
        for (int r = 0; r < 16; ++r) { const int orow = crow(r, hi); const float rli = __builtin_amdgcn_rcpf(wsf[32 + orow]);
            stg[orow * 64 + r32] = f2bf(o0[r] * rli); stg[orow * 64 + 32 + r32] = f2bf(o1[r] * rli); }
        asm volatile("s_waitcnt lgkmcnt(0)" ::: "memory");
#pragma unroll
        for (int i = 0; i < 4; ++i) { const int row = i * 8 + (lane >> 3), ch = lane & 7; const u32x4 v = *(const LAS u32x4*)(stg + row * 64 + ch * 8);
            st16(AOPQ + (rowb + 128 * n + q0 + row) * KAB + h * 64 + ch * 8, v); }
        asm volatile("s_waitcnt lgkmcnt(0)" ::: "memory");
    }
}
}

constexpr size_t MiB = 1u << 20;
constexpr size_t WS_CTL = 0, CTL_ZERO_BYTES = 64 * 1024;
constexpr size_t WS_RS = 256 * 1024;
constexpr size_t RS_BYTES = (size_t)MTOK * 4 * 4;
constexpr size_t WS_WUP1 = 2 * MiB;
constexpr size_t WS_WDN1 = WS_WUP1 + 11 * MiB;
constexpr size_t WS_WIN = WS_WDN1 + 11 * MiB / 2;
constexpr size_t WS_WAB = WS_WIN + 13 * MiB / 2;
constexpr size_t WS_WO = WS_WAB + 3 * MiB;
constexpr size_t WS_WUP2 = WS_WO + 2 * MiB;
constexpr size_t WS_WDN2 = WS_WUP2 + 11 * MiB;
constexpr size_t WS_TM = WS_WDN2 + 11 * MiB / 2;
constexpr size_t WS_SLAB0 = WS_TM + 16 * MiB;
constexpr size_t WS_XB = WS_SLAB0, WS_AFF = WS_SLAB0 + 4 * MiB, WS_QKV = WS_SLAB0 + 4 * MiB, WS_FT = WS_SLAB0 + 7 * MiB, WS_GATES = WS_SLAB0 + 9 * MiB, WS_AOPQ = WS_SLAB0 + 17 * MiB;
constexpr size_t WS_END = WS_SLAB0 + 8 * SLAB;
static_assert(WS_END <= 256 * MiB && WS_RS + 4 * RS_BYTES <= WS_WUP1, "d_ws map");
static_assert((size_t)SEQ * DM * 2 == 4 * MiB && (size_t)SEQ * DFF * 2 == 11 * MiB && (size_t)SEQ * 768 * 2 == 3 * MiB && (size_t)512 * SEQ * 2 == 2 * MiB && (size_t)SEQ * 2048 * 2 == 8 * MiB && (size_t)SEQ * KAB * 2 == 6 * MiB, "slab pieces");

constexpr int RING_BYTES = 131072, LDSCTL_OFF = RING_BYTES, MISC_OFF = LDSCTL_OFF + 320, BIAS_OFF = LDSCTL_OFF + 512, WSF_OFF = BIAS_OFF + 4 * 260 * 4, LDS_BYTES = 147456;
static_assert(WSF_OFF + 8 * 64 * 4 <= LDS_BYTES, "LDS map");

#define XB_TMO      128
#define XB_XCNT(j)  (256  + 64 * (j))
#define XB_XSUB(j)  (1280 + 64 * (j))
#define XB_XGEN(j)  (2304 + 64 * (j))
#define XB_TOP      3328
#define XB_TOPGEN   3392
#define XCD_BAR_WORDS 3456
#define XB_SPIN_CAP (1u << 18)
__device__ __forceinline__ unsigned xb_ld(unsigned* p)              { return __hip_atomic_load(p, __ATOMIC_RELAXED, __HIP_MEMORY_SCOPE_AGENT); }
__device__ __forceinline__ unsigned xb_add(unsigned* p, unsigned v) { return __hip_atomic_fetch_add(p, v, __ATOMIC_RELAXED, __HIP_MEMORY_SCOPE_AGENT); }
__device__ __forceinline__ unsigned xb_xcc_id() { return (unsigned)__builtin_amdgcn_s_getreg((3 << 11) | 20) & 0xFu; }
#define XB_SPIN(cond, bar) do { unsigned _sp = 0; while (cond) { __builtin_amdgcn_s_sleep(1); \
    if ((++_sp & 255u) == 0u) { if (xb_ld(&(bar)[XB_TMO])) break; if (_sp > XB_SPIN_CAP) { atomicAdd(&(bar)[XB_TMO], 1u); break; } } } } while (0)
struct XcdBarrier { unsigned* bar; unsigned x; volatile LAS unsigned* st; };
__device__ __forceinline__ XcdBarrier xcd_barrier_post(unsigned* bar, volatile LAS unsigned* st) {
    XcdBarrier b; b.bar = bar; b.x = xb_xcc_id(); b.st = st;
    if (threadIdx.x == 0) (void)xb_add(&bar[XB_XCNT(b.x)], 1u);
    return b;
}
__device__ __forceinline__ void xcd_barrier_complete(unsigned* bar, unsigned x, unsigned& nloc, unsigned& nx) {
    const unsigned G = gridDim.x * gridDim.y * gridDim.z;
    unsigned sum, cnt, mine, sp = 0u;
    for (;;) {
        sum = 0u; cnt = 0u; mine = 0u;
#pragma unroll
        for (unsigned j = 0; j < 16; ++j) { const unsigned c = xb_ld(&bar[XB_XCNT(j)]); sum += c; cnt += (c > 0u) ? 1u : 0u; mine = (j == x) ? c : mine; }
        if (sum == G) break;
        __builtin_amdgcn_s_sleep(1);
        if ((++sp & 255u) == 0u) { if (xb_ld(&bar[XB_TMO])) break; if (sp > XB_SPIN_CAP) { atomicAdd(&bar[XB_TMO], 1u); break; } }
    }
    nloc = mine > 0u ? mine : 1u; nx = cnt > 0u ? cnt : 1u;
}
__device__ __forceinline__ void xcd_barrier(const XcdBarrier& b) {
    asm volatile("s_waitcnt vmcnt(0)" ::: "memory");
    __syncthreads();
    if (threadIdx.x == 0) {
        unsigned* bar = b.bar;
        __builtin_amdgcn_s_waitcnt(0);
        unsigned nloc = b.st[0], nx = b.st[1];
        if (nloc == 0u) { xcd_barrier_complete(bar, b.x, nloc, nx); b.st[0] = nloc; b.st[1] = nx; }
        const unsigned old = xb_add(&bar[XB_XSUB(b.x)], 1u);
        const unsigned gen = old / nloc;
        if (old + 1u == (gen + 1u) * nloc) {
            __builtin_amdgcn_fence(__ATOMIC_RELEASE, "agent");
            asm volatile("s_waitcnt vmcnt(0)" ::: "memory");
            const unsigned og = xb_add(&bar[XB_TOP], 1u);
            const unsigned tg = og / nx;
            if (og + 1u == (tg + 1u) * nx) xb_add(&bar[XB_TOPGEN], 1u);
            else XB_SPIN(xb_ld(&bar[XB_TOPGEN]) == tg, bar);
            __builtin_amdgcn_fence(__ATOMIC_ACQUIRE, "agent");
            xb_add(&bar[XB_XGEN(b.x)], 1u);
            asm volatile("s_waitcnt vmcnt(0)" ::: "memory");
        } else {
            XB_SPIN(xb_ld(&bar[XB_XGEN(b.x)]) == gen, bar);
            __builtin_amdgcn_fence(__ATOMIC_ACQUIRE, "agent");
            asm volatile("s_waitcnt vmcnt(0)" ::: "memory");
        }
    }
    __syncthreads();
}


__device__ __forceinline__ void group_barrier(unsigned* cnt, unsigned target, bool pure, unsigned* tmo) {
    asm volatile("s_waitcnt vmcnt(0)" ::: "memory");
    __syncthreads();
    if (threadIdx.x == 0) {
        if (!pure) { __builtin_amdgcn_fence(__ATOMIC_RELEASE, "agent"); asm volatile("s_waitcnt vmcnt(0)" ::: "memory"); }
        (void)xb_add(cnt, 1u);
        unsigned sp = 0u;
        while (xb_ld(cnt) < target) { __builtin_amdgcn_s_sleep(1); if ((++sp & 255u) == 0u) { if (xb_ld(tmo)) break; if (sp > XB_SPIN_CAP) { atomicAdd(tmo, 1u); break; } } }
        __builtin_amdgcn_fence(__ATOMIC_ACQUIRE, "agent");
        asm volatile("s_waitcnt vmcnt(0)" ::: "memory");
    }
    __syncthreads();
}


struct EpiFinal {
    static constexpr bool AFTER_DRAIN = true; static constexpr int MID_T = -1;
    const float* xin; float* out; float* RSo; const float* gfin; float alpha; unsigned* cnt; unsigned target; bool pure; unsigned* tmo;
    __device__ __forceinline__ void mid(Acc&, const Unit&, int, int, int, int) const {}
    __device__ __forceinline__ void operator()(const Acc&, const Unit&, int, int, int, int) const {}
    __device__ __forceinline__ void fused(Acc& acc, const Unit& u, int wr, int wc, int fr, int fq, LAS unsigned char* lds, int wid, int lane) const {
        asm volatile("" : "+v"(fr), "+v"(fq));
        LAS float* P = (LAS float*)lds;
#pragma unroll
        for (int ai = 0; ai < 2; ++ai)
#pragma unroll
            for (int m = 0; m < 4; ++m) {
                const int rl = ai * 128 + wr * 64 + m * 16 + fr, row = u.pm * 256 + rl; float ss = 0.f;
#pragma unroll
                for (int bj = 0; bj < 2; ++bj) {
                    const size_t off = (size_t)row * DM + u.pn * 256 + bj * 128 + wc * 32 + 8 * fq;
                    f32x4 x0 = *(const f32x4*)(xin + off), x1 = *(const f32x4*)(xin + off + 4);
                    x0 = x0 + acc[ai][bj][m][0] * alpha; x1 = x1 + acc[ai][bj][m][1] * alpha;
                    acc[ai][bj][m][0] = x0; acc[ai][bj][m][1] = x1;
                    ss += (x0[0] * x0[0] + x0[1] * x0[1]) + (x0[2] * x0[2] + x0[3] * x0[3]) + (x1[0] * x1[0] + x1[1] * x1[1]) + (x1[2] * x1[2] + x1[3] * x1[3]);
                }
                ss += __shfl_xor(ss, 16); ss += __shfl_xor(ss, 32);
                if (fq == 0) P[rl * 4 + wc] = ss;
            }
        asm volatile("s_waitcnt lgkmcnt(0)" ::: "memory"); __builtin_amdgcn_s_barrier(); asm volatile("" ::: "memory");
        const int tid = wid * 64 + lane;
        if (tid < 256) { const f32x4 p = *(const LAS f32x4*)(P + tid * 4); RSo[(size_t)(u.pm * 256 + tid) * 4 + u.pn] = (p[0] + p[1]) + (p[2] + p[3]); }
        group_barrier(cnt, target, pure, tmo);
        asm volatile("" : "+v"(fr), "+v"(fq));
        f32x4 gv[2][2];
#pragma unroll
        for (int bj = 0; bj < 2; ++bj)
#pragma unroll
            for (int n = 0; n < 2; ++n) gv[bj][n] = *(const f32x4*)(gfin + u.pn * 256 + bj * 128 + wc * 32 + 8 * fq + 4 * n);
#pragma unroll
        for (int ai = 0; ai < 2; ++ai)
#pragma unroll
            for (int m = 0; m < 4; ++m) {
                const int row = u.pm * 256 + ai * 128 + wr * 64 + m * 16 + fr; const float r = row_rinv(RSo, row);
#pragma unroll
                for (int bj = 0; bj < 2; ++bj) { const size_t off = (size_t)row * DM + u.pn * 256 + bj * 128 + wc * 32 + 8 * fq;
                    st16f(out + off, acc[ai][bj][m][0] * gv[bj][0] * r); st16f(out + off + 4, acc[ai][bj][m][1] * gv[bj][1] * r); }
            }
    }
};

__device__ __forceinline__ float wave_sum(float v) {
#pragma unroll
    for (int o = 1; o < 64; o <<= 1) v += __shfl_xor(v, o);
    return v;
}
__device__ __forceinline__ void transpose_item(const float* W, int ldsrc, int srccol0, int k0, const float* gk, float cs, bf16_t* WT, int ldd, int drow0, LAS float* scr, int lane) {
#pragma unroll 8
    for (int i = 0; i < 32; ++i) { const int kk = 2 * i + (lane >> 5); float v = W[(size_t)(k0 + kk) * ldsrc + srccol0 + (lane & 31)]; if (gk) v *= gk[k0 + kk]; scr[kk * 33 + (lane & 31)] = v * cs; }
    asm volatile("s_waitcnt lgkmcnt(0)" ::: "memory");
    const int c = lane & 7;
#pragma unroll
    for (int j = 0; j < 4; ++j) { const int n = (lane >> 3) + 8 * j; const LAS float* s = scr + (8 * c) * 33 + n;
        u32x4 o; o.x = cvtpk(s[0 * 33], s[1 * 33]); o.y = cvtpk(s[2 * 33], s[3 * 33]); o.z = cvtpk(s[4 * 33], s[5 * 33]); o.w = cvtpk(s[6 * 33], s[7 * 33]);
        *(u32x4*)(WT + (size_t)(drow0 + n) * ldd + k0 + 8 * c) = o; }
    asm volatile("s_waitcnt lgkmcnt(0)" ::: "memory");
}
__device__ __forceinline__ int map_up(int rho) { const int pn = rho >> 8, i = rho & 255; return i < 128 ? 128 * pn + i : DFF + 128 * pn + (i - 128); }
__device__ __forceinline__ int map_in(int rho) { if (rho < 1280) return rho; const int t = (rho - 1280) >> 8, i = (rho - 1280) & 255; return i < 128 ? 1280 + 128 * t + i : 2304 + 128 * t + (i - 128); }

struct Args { const float* in[16]; float* out; unsigned char* ws; };

__global__ void __launch_bounds__(512, 2) mega_fwd(Args args) {
    extern __shared__ __attribute__((aligned(16))) unsigned char lds_raw[];
    LAS unsigned char* lds = (LAS unsigned char*)lds_raw;
    volatile LAS unsigned* MISC = (volatile LAS unsigned*)(lds + MISC_OFF);
    const int tid = threadIdx.x, lane = tid & 63, wave = __builtin_amdgcn_readfirstlane(tid >> 6);
    const int G = gridDim.x, bx = blockIdx.x;
    const int vcu = (G % 8 == 0) ? (bx % 8) * (G / 8) + bx / 8 : bx;
    unsigned char* ws = args.ws;
    unsigned* ctl = (unsigned*)(ws + WS_CTL);
    const float* x = args.in[0]; const float* g_ffn1 = args.in[1]; const float* w_up1 = args.in[2]; const float* w_dn1 = args.in[3]; const float* g_mix = args.in[4]; const float* w_in = args.in[5];
    const float* b_gate = args.in[6]; const float* sink = args.in[7]; const float* rel_bias = args.in[8]; const float* w_a = args.in[9]; const float* w_b = args.in[10]; const float* w_o = args.in[11];
    const float* g_ffn2 = args.in[12]; const float* w_up2 = args.in[13]; const float* w_dn2 = args.in[14]; const float* g_final = args.in[15];
    float* out = args.out;
    bf16_t* Wup1 = (bf16_t*)(ws + WS_WUP1); bf16_t* Wdn1 = (bf16_t*)(ws + WS_WDN1); bf16_t* Win = (bf16_t*)(ws + WS_WIN); bf16_t* Wab = (bf16_t*)(ws + WS_WAB); bf16_t* Wo = (bf16_t*)(ws + WS_WO);
    bf16_t* Wup2 = (bf16_t*)(ws + WS_WUP2); bf16_t* Wdn2 = (bf16_t*)(ws + WS_WDN2); bf16_t* Tm = (bf16_t*)(ws + WS_TM); bf16_t* XB = (bf16_t*)(ws + WS_XB);
    bf16_t* AFF = (bf16_t*)(ws + WS_AFF); bf16_t* QKV = (bf16_t*)(ws + WS_QKV); bf16_t* FT = (bf16_t*)(ws + WS_FT); bf16_t* GATES = (bf16_t*)(ws + WS_GATES); bf16_t* AOPQ = (bf16_t*)(ws + WS_AOPQ);
    float* RS0 = (float*)(ws + WS_RS); float* RS1 = (float*)(ws + WS_RS + RS_BYTES); float* RS2 = (float*)(ws + WS_RS + 2 * RS_BYTES); float* RS3 = (float*)(ws + WS_RS + 3 * RS_BYTES);

    for (int u = tid; u < (LDS_BYTES - LDSCTL_OFF) / 4; u += 512) ((LAS unsigned*)(lds + LDSCTL_OFF))[u] = 0u;
    __syncthreads();
    XcdBarrier bar = xcd_barrier_post(ctl + 1024, MISC + 8);
    unsigned* grp_cnt = ctl + 8192 + 64 * (bx & 7); unsigned* grp_census = ctl + 6144 + 16 * (bx & 7); unsigned grp_gen = 0u; bool grp_pure = false;
    if (tid == 0) (void)xb_add(grp_census + (bar.x & 15u), 1u);
#define GRID_BAR() xcd_barrier(bar)
#define GROUP_BAR() do { ++grp_gen; group_barrier(grp_cnt, grp_gen * (unsigned)(G / 8), grp_pure, ctl + 1024 + XB_TMO); } while (0)
#ifndef REPEAT
#define REPEAT -1
#endif
#ifndef NREP
#define NREP 2
#endif
#define PH(n) for (int rep_ = 0; rep_ < ((n) == REPEAT ? NREP : 1); ++rep_)

    PH(0) {
        const int gw = vcu * 8 + wave, NGW = G * 8;
        LAS float* cosT = (LAS float*)(lds + 8 * 8448);
        for (int j = tid; j < 2048; j += 512) cosT[j] = cospif((float)j * (1.0f / 1024.0f));
        __syncthreads();
        {
            LAS float* scr = (LAS float*)(lds + wave * 8448);
            constexpr int I_UP = 16 * (NUP / 32), I_DN = (DFF / 64) * (DM / 32), I_IN = 16 * (INW / 32), I_A = 8 * 32, I_O = 16 * 32;
            constexpr int NITEMS = 2 * I_UP + 2 * I_DN + I_IN + I_A + I_O;
            const int kr = lane >> 3, c4 = lane & 7;
            struct TI { const float* src; const float* gk; bf16_t* dst; int ldsrc, ldd, k0; float cs; };
            auto decode = [&](int it, TI& t) {
                int r = it;
                if (r < 2 * I_UP) { const int second = r >= I_UP; if (second) r -= I_UP; const int nb = r % (NUP / 32), kb = r / (NUP / 32);
                    t.src = (second ? w_up2 : w_up1) + map_up(32 * nb); t.ldsrc = NUP; t.gk = second ? g_ffn2 : g_ffn1; t.cs = 1.0f; t.dst = (second ? Wup2 : Wup1) + (size_t)(32 * nb) * DM; t.ldd = DM; t.k0 = 64 * kb; return; }
                r -= 2 * I_UP;
                if (r < 2 * I_DN) { const int second = r >= I_DN; if (second) r -= I_DN; const int nb = r % 32, kb = r / 32;
                    t.src = (second ? w_dn2 : w_dn1) + 32 * nb; t.ldsrc = DM; t.gk = nullptr; t.cs = 1.0f; t.dst = (second ? Wdn2 : Wdn1) + (size_t)(32 * nb) * DFF; t.ldd = DFF; t.k0 = 64 * kb; return; }
                r -= 2 * I_DN;
                if (r < I_IN) { const int nb = r % (INW / 32), kb = r / (INW / 32);
                    t.src = w_in + map_in(32 * nb); t.ldsrc = INW; t.gk = g_mix; t.cs = (32 * nb < 512) ? QSCALE : 1.0f; t.dst = Win + (size_t)(32 * nb) * DM; t.ldd = DM; t.k0 = 64 * kb; return; }
                r -= I_IN;
                if (r < I_A) { const int nb = r % 32, kb = r / 32; t.src = w_a + 32 * nb; t.ldsrc = DM; t.gk = nullptr; t.cs = 1.0f; t.dst = Wab + (size_t)(32 * nb) * KAB; t.ldd = KAB; t.k0 = 64 * kb; return; }
                r -= I_A;
                { const int nb = r % 32, kb = r / 32; t.src = w_o + 32 * nb; t.ldsrc = DM; t.gk = nullptr; t.cs = 1.0f; t.dst = Wo + (size_t)(32 * nb) * DM; t.ldd = DM; t.k0 = 64 * kb; }
            };
            f32x4 cur[8], nxt[8]; float gc[8], gn[8];
            TI tc, tn;
            int it = gw;
            if (it < NITEMS) { decode(it, tc);
#pragma unroll
                for (int i = 0; i < 8; ++i) { const int k = tc.k0 + 8 * i + kr; cur[i] = *(const f32x4*)(tc.src + (size_t)k * tc.ldsrc + 4 * c4); gc[i] = tc.gk ? tc.gk[k] : 1.0f; } }
            while (it < NITEMS) {
                const int itn = it + NGW; const bool hn = itn < NITEMS;
                if (hn) { decode(itn, tn);
#pragma unroll
                    for (int i = 0; i < 8; ++i) { const int k = tn.k0 + 8 * i + kr; nxt[i] = *(const f32x4*)(tn.src + (size_t)k * tn.ldsrc + 4 * c4); gn[i] = tn.gk ? tn.gk[k] : 1.0f; } }
#pragma unroll
                for (int i = 0; i < 8; ++i) { const float sc = gc[i] * tc.cs; LAS float* p = scr + (8 * i + kr) * 33 + 4 * c4; p[0] = cur[i][0] * sc; p[1] = cur[i][1] * sc; p[2] = cur[i][2] * sc; p[3] = cur[i][3] * sc; }
                asm volatile("s_waitcnt lgkmcnt(0)" ::: "memory");
                { const int c = lane & 7;
#pragma unroll
                  for (int j = 0; j < 4; ++j) { const int n = (lane >> 3) + 8 * j; const LAS float* s = scr + (8 * c) * 33 + n;
                      u32x4 o; o.x = cvtpk(s[0 * 33], s[1 * 33]); o.y = cvtpk(s[2 * 33], s[3 * 33]); o.z = cvtpk(s[4 * 33], s[5 * 33]); o.w = cvtpk(s[6 * 33], s[7 * 33]);
                      st16(tc.dst + (size_t)n * tc.ldd + tc.k0 + 8 * c, o); } }
                asm volatile("s_waitcnt lgkmcnt(0)" ::: "memory");
                if (hn) { tc = tn;
#pragma unroll
                    for (int i = 0; i < 8; ++i) { cur[i] = nxt[i]; gc[i] = gn[i]; } }
                it = itn;
            }
        }
        {
            f32x4 v[4], w[4]; int m = gw;
            if (m < MTOK) { const f32x4* xr = (const f32x4*)(x + (size_t)m * DM) + 2 * lane;
#pragma unroll
                for (int j = 0; j < 2; ++j) { v[2 * j] = xr[128 * j]; v[2 * j + 1] = xr[128 * j + 1]; } }
            while (m < MTOK) {
                const int mn = m + NGW;
                if (mn < MTOK) { const f32x4* xr = (const f32x4*)(x + (size_t)mn * DM) + 2 * lane;
#pragma unroll
                    for (int j = 0; j < 2; ++j) { w[2 * j] = xr[128 * j]; w[2 * j + 1] = xr[128 * j + 1]; } }
                float s = 0.f;
#pragma unroll
                for (int j = 0; j < 4; ++j) s += (v[j][0] * v[j][0] + v[j][1] * v[j][1]) + (v[j][2] * v[j][2] + v[j][3] * v[j][3]);
                s = wave_sum(s);
#pragma unroll
                for (int j = 0; j < 2; ++j) st16(brow(XB, m, DM) + 512 * j + 8 * lane, pack8(v[2 * j], v[2 * j + 1]));
                if (lane == 0) *(f32x4*)(RS0 + (size_t)m * 4) = (f32x4){s, 0.f, 0.f, 0.f};
#pragma unroll
                for (int j = 0; j < 4; ++j) v[j] = w[j];
                m = mn;
            }
        }
        {
            LAS float* tab = (LAS float*)(lds + 8 * 8448 + 8192 + wave * 4096);
            for (int item = gw; item < 2048; item += NGW) {
                const int kg = item >> 4, ng = item & 15, g = kg >> 5, j0 = (8 * kg) & 255, part = j0 >> 7, c0 = j0 & 127, n = 64 * ng + lane;
#pragma unroll
                for (int i = 0; i < 16; ++i) { const int idx = lane + 64 * i, cp = idx >> 3, e = idx & 7, ph = ((c0 + e) * cp) & 127; tab[idx] = part ? -cosT[(16 * ph - 512) & 2047] : cosT[16 * ph]; }
                asm volatile("s_waitcnt lgkmcnt(0)" ::: "memory");
                float a8[8];
#pragma unroll
                for (int e = 0; e < 8; ++e) a8[e] = 0.f;
                const float* wp = w_b + (size_t)(g * 128) * DM + n;
#pragma unroll 8
                for (int cp = 0; cp < 128; ++cp) { const float w = wp[(size_t)cp * DM]; const f32x4 t0 = *(const LAS f32x4*)(tab + cp * 8), t1 = *(const LAS f32x4*)(tab + cp * 8 + 4);
                    a8[0] += w * t0[0]; a8[1] += w * t0[1]; a8[2] += w * t0[2]; a8[3] += w * t0[3]; a8[4] += w * t1[0]; a8[5] += w * t1[1]; a8[6] += w * t1[2]; a8[7] += w * t1[3]; }
                const float sc = 0.08838834764831845f;
                u32x4 o; o.x = cvtpk(a8[0] * sc, a8[1] * sc); o.y = cvtpk(a8[2] * sc, a8[3] * sc); o.z = cvtpk(a8[4] * sc, a8[5] * sc); o.w = cvtpk(a8[6] * sc, a8[7] * sc);
                st16(Wab + (size_t)n * KAB + 512 + 8 * kg, o);
                asm volatile("s_waitcnt lgkmcnt(0)" ::: "memory");
            }
        }
        for (int idx = vcu * 512 + tid; idx < 4096 * 256; idx += G * 512) {
            const int rT = idx >> 8, s0 = (idx & 255) * 8, part = rT >> 11, k = rT & 2047; const float sc = 0.022097086912079608f;
            float v[8];
#pragma unroll
            for (int e = 0; e < 8; ++e) { const int ph = (k * (s0 + e)) & 2047; v[e] = cosT[part ? ((ph - 512) & 2047) : ph] * sc; }
            u32x4 o; o.x = cvtpk(v[0], v[1]); o.y = cvtpk(v[2], v[3]); o.z = cvtpk(v[4], v[5]); o.w = cvtpk(v[6], v[7]);
            st16(Tm + (size_t)rT * SEQ + s0, o);
        }
        __syncthreads();
    }
    GRID_BAR();
    grp_pure = (G % 8 == 0) && (xb_ld(grp_census + (bar.x & 15u)) == (unsigned)(G / 8));

    PH(1) { SchedPlain S; S.T.init(MTOK, NUP, G, bx); S.A = (const char*)XB; S.Bt = (const char*)Wup1; S.tA = (size_t)256 * DM * 2; S.tB = (size_t)256 * DM * 2;
      EpiSwiGLU E{RS0, AFF}; pg8::gemm_phase<EpiSwiGLU, SchedPlain, true>(lds, pg8::GemmP{DM, DM, DM}, S, E); }
    GROUP_BAR();
    PH(2) { SchedPlain S; S.T.init(MTOK, DM, G, bx); S.A = (const char*)AFF; S.Bt = (const char*)Wdn1; S.tA = (size_t)256 * DFF * 2; S.tB = (size_t)256 * DFF * 2;
      EpiResid E{x, out, XB, RS1, 0.5f}; pg8::gemm_phase<EpiResid, SchedPlain, false>(lds, pg8::GemmP{DFF, DFF, DFF}, S, E); }
    GROUP_BAR();
    PH(3) { SchedWin S; S.T.init(MTOK, INW, G, bx); S.X = (const char*)XB; S.W = (const char*)Win; S.tX = (size_t)256 * DM * 2; S.tW = (size_t)256 * DM * 2;
      EpiWin E{RS1, b_gate, QKV, FT, GATES}; pg8::gemm_phase<EpiWin, SchedWin, true>(lds, pg8::GemmP{DM, DM, DM}, S, E); }
    GROUP_BAR();
    { const int b = bx & 7, j = bx >> 3;
      PH(41) { SchedOne S; S.u0 = Unit{j >> 1, j & 1}; S.A = (const char*)(Tm + (size_t)(j >> 1) * 256 * SEQ); S.Bt = (const char*)(FT + (size_t)b * SLAB_E + (size_t)(j & 1) * 256 * SEQ);
        EpiDft E{AOPQ, b}; pg8::gemm_phase<EpiDft, SchedOne, false>(lds, pg8::GemmP{SEQ, SEQ, SEQ}, S, E); }
      PH(42) { att::attn_unit(lds, (LAS float*)(lds + BIAS_OFF), (LAS float*)(lds + WSF_OFF), QKV, AOPQ, sink, rel_bias, b, j & 1, j >> 1);
        asm volatile("s_waitcnt lgkmcnt(0)" ::: "memory"); __builtin_amdgcn_s_barrier(); }
    }
    GROUP_BAR();
    PH(5) { SchedPlain S; S.T.init(MTOK, DM, G, bx); S.A = (const char*)AOPQ; S.Bt = (const char*)Wab; S.tA = (size_t)256 * KAB * 2; S.tB = (size_t)256 * KAB * 2;
      EpiGate E{GATES}; pg8::gemm_phase<EpiGate, SchedPlain, false>(lds, pg8::GemmP{KAB, KAB, KAB}, S, E); }
    GROUP_BAR();
    PH(6) { SchedPlain S; S.T.init(MTOK, DM, G, bx); S.A = (const char*)GATES; S.Bt = (const char*)Wo; S.tA = (size_t)256 * 2048 * 2; S.tB = (size_t)256 * DM * 2;
      EpiResid E{out, out, XB, RS2, 1.0f}; pg8::gemm_phase<EpiResid, SchedPlain, false>(lds, pg8::GemmP{DM, 2048, DM}, S, E); }
    GROUP_BAR();
    PH(7) { SchedPlain S; S.T.init(MTOK, NUP, G, bx); S.A = (const char*)XB; S.Bt = (const char*)Wup2; S.tA = (size_t)256 * DM * 2; S.tB = (size_t)256 * DM * 2;
      EpiSwiGLU E{RS2, AFF}; pg8::gemm_phase<EpiSwiGLU, SchedPlain, true>(lds, pg8::GemmP{DM, DM, DM}, S, E); }
    GROUP_BAR();
    PH(8) { SchedPlain S; S.T.init(MTOK, DM, G, bx); S.A = (const char*)AFF; S.Bt = (const char*)Wdn2; S.tA = (size_t)256 * DFF * 2; S.tB = (size_t)256 * DFF * 2;
      ++grp_gen; EpiFinal E{out, out, RS3, g_final, 0.5f, grp_cnt, grp_gen * (unsigned)(G / 8), grp_pure, ctl + 1024 + XB_TMO};
      pg8::gemm_phase<EpiFinal, SchedPlain, false>(lds, pg8::GemmP{DFF, DFF, DFF}, S, E); }
}

extern "C" void kernel_launch(void* const* d_in, const int* in_sizes, int n_in, void* d_out, int out_size, void* d_ws, size_t ws_size, hipStream_t stream) {
    static int grid = 0;
    if (grid == 0) {
        if (n_in != 16 || in_sizes[0] != MTOK * DM || out_size != MTOK * DM || ws_size < WS_END) { fprintf(stderr, "kernel_launch: unexpected shapes (n_in %d, ws %zu)\n", n_in, ws_size); grid = -1; return; }
        int dev = 0, cus = 0, per_cu = 0;
        if (hipGetDevice(&dev) != hipSuccess || hipDeviceGetAttribute(&cus, hipDeviceAttributeMultiprocessorCount, dev) != hipSuccess) { grid = -1; return; }
        if (hipFuncSetAttribute((const void*)mega_fwd, hipFuncAttributeMaxDynamicSharedMemorySize, LDS_BYTES) != hipSuccess) { fprintf(stderr, "kernel_launch: hipFuncSetAttribute failed\n"); grid = -1; return; }
        if (hipOccupancyMaxActiveBlocksPerMultiprocessor(&per_cu, (const void*)mega_fwd, 512, LDS_BYTES) != hipSuccess || per_cu < 1) { fprintf(stderr, "kernel_launch: occupancy query says %d\n", per_cu); }
        (void)hipGetLastError();
        grid = cus;
        if (grid != 256) { fprintf(stderr, "kernel_launch: needs 256 CUs, device has %d\n", cus); grid = -1; return; }
    }
    if (grid < 0) return;
    if (hipMemsetAsync((char*)d_ws + WS_CTL, 0, CTL_ZERO_BYTES, stream) != hipSuccess) return;
    Args a{};
    for (int i = 0; i < 16; ++i) a.in[i] = (const float*)d_in[i];
    a.out = (float*)d_out; a.ws = (unsigned char*)d_ws;
    hipLaunchKernelGGL(mega_fwd, dim3(grid), dim3(512), LDS_BYTES, stream, a);
}
```

```cpp
#include <hip/hip_runtime.h>
#include <cstdio>
#include <cstdint>
#include <cmath>

#ifndef PROBE_K
#define PROBE_K -1
#endif
#define LAS __attribute__((address_space(3)))
#define GAS __attribute__((address_space(1)))
typedef unsigned short bf16_t;
typedef short bf16x8 __attribute__((ext_vector_type(8)));
typedef float f32x4 __attribute__((ext_vector_type(4)));
typedef float f32x16 __attribute__((ext_vector_type(16)));
typedef unsigned u32x4 __attribute__((ext_vector_type(4)));
typedef float f32x2_t __attribute__((ext_vector_type(2)));
typedef __bf16 bf16x2_t __attribute__((ext_vector_type(2)));
typedef short s16x4 __attribute__((ext_vector_type(4)));

constexpr int DM = 1024, NB = 8, SEQ = 2048, MTOK = NB * SEQ, DFF = 2816, NUP = 2 * DFF, INW = 3328;
constexpr int KAB = 1536;
constexpr float LOG2E = 1.4426950408889634f;
constexpr float QSCALE = 0.125f * LOG2E;
constexpr float RMS_EPS = 1e-6f;
constexpr size_t SLAB = (size_t)23 << 20, SLAB_E = SLAB / 2;
__device__ __forceinline__ unsigned short* brow(unsigned short* base, int row, int pitch) { return base + (size_t)(row >> 11) * SLAB_E + (size_t)(row & 2047) * pitch; }
__device__ __forceinline__ const unsigned short* brow(const unsigned short* base, int row, int pitch) { return base + (size_t)(row >> 11) * SLAB_E + (size_t)(row & 2047) * pitch; }

__device__ __forceinline__ unsigned cvtpk(float lo, float hi) { f32x2_t v = {lo, hi}; bf16x2_t b = __builtin_convertvector(v, bf16x2_t); return __builtin_bit_cast(unsigned, b); }
__device__ __forceinline__ u32x4 pack8(f32x4 a, f32x4 b) { u32x4 w; w.x = cvtpk(a[0], a[1]); w.y = cvtpk(a[2], a[3]); w.z = cvtpk(b[0], b[1]); w.w = cvtpk(b[2], b[3]); return w; }
#ifndef WT_STORES
#define WT_STORES 0
#endif
__device__ __forceinline__ void st16(void* p, u32x4 v) {
#if WT_STORES
    asm volatile("global_store_dwordx4 %0, %1, off sc1\n\ts_nop 1" :: "v"(p), "v"(v) : "memory");
#else
    *(u32x4*)p = v;
#endif
}
__device__ __forceinline__ void st16f(void* p, f32x4 v) { st16(p, __builtin_bit_cast(u32x4, v)); }
__device__ __forceinline__ void unpack8(u32x4 w, f32x4& a, f32x4& b) {
    a[0] = __builtin_bit_cast(float, w.x << 16); a[1] = __builtin_bit_cast(float, w.x & 0xffff0000u); a[2] = __builtin_bit_cast(float, w.y << 16); a[3] = __builtin_bit_cast(float, w.y & 0xffff0000u);
    b[0] = __builtin_bit_cast(float, w.z << 16); b[1] = __builtin_bit_cast(float, w.z & 0xffff0000u); b[2] = __builtin_bit_cast(float, w.w << 16); b[3] = __builtin_bit_cast(float, w.w & 0xffff0000u);
}
__device__ __forceinline__ float bf2f(unsigned short h) { return __builtin_bit_cast(float, (unsigned)h << 16); }
__device__ __forceinline__ float row_rinv(const float* RS, int row) { const f32x4 p = *(const f32x4*)(RS + 4 * (size_t)row); return rsqrtf(((p[0] + p[1]) + (p[2] + p[3])) * (1.0f / DM) + RMS_EPS); }

namespace pg8 {
constexpr int BM = 256, BK = 64, HALF = 128, HTB = HALF * BK * 2, STAGE_BYTES = 8 * HTB, NXCD = 8, WGM = 8;
__host__ __device__ __forceinline__ int lds_byte(int r, int c) { const int st = (r >> 4) * 2 + (c >> 5), rr = r & 15, cc = c & 31, ob = rr * 64 + cc * 2; return st * 1024 + (ob ^ (((ob >> 9) & 1) << 5)); }
__host__ __device__ __forceinline__ void stage_rc(int b, int& R, int& C) { const int st = b / 1024, sb = b % 1024, swz = sb ^ (((sb >> 9) & 1) << 5); R = (st >> 1) * 16 + swz / 64; C = (st & 1) * 32 + (swz % 64) / 2; }
__host__ __device__ __forceinline__ int perm32(int rho) { const int n = rho >> 4, i = rho & 15; return 8 * (i >> 2) + 4 * n + (i & 3); }

struct Unit { int pm, pn; };
struct GemmP { int K, lda, ldb; };

struct TileOrder {
    int nM, nN, nwg, G, c;
    __device__ void init(int M, int N, int G_, int c_) { nM = M / BM; nN = N / BM; nwg = nM * nN; G = G_; c = c_; }
    __device__ bool tile(int i, Unit& u) const {
        const long L = (long)i * G + c; if (L >= nwg) return false;
        int wgid = (int)L; { const int q = nwg / NXCD, r = nwg % NXCD, xcd = wgid % NXCD, off = wgid / NXCD; wgid = (xcd < r ? xcd * (q + 1) : r * (q + 1) + (xcd - r) * q) + off; }
        const int nig = WGM * nN, gid = wgid / nig, fm = gid * WGM, gsz = (nM - fm) < WGM ? (nM - fm) : WGM;
        u.pm = fm + ((wgid % nig) % gsz); u.pn = (wgid % nig) / gsz; return true;
    }
};

template <class Epi, class Sched, bool ALIGN_EPI>
__device__ __forceinline__ void gemm_phase(LAS unsigned char* lds, const GemmP g, const Sched& S, const Epi& E) {
    int tid = threadIdx.x; asm volatile("" : "+v"(tid));
    const int wid = __builtin_amdgcn_readfirstlane(tid >> 6), lane = tid & 63, wr = wid >> 2, wc = wid & 3, fr = lane & 15, fq = lane >> 4;
    const int K = g.K, nt = K / BK;
    unsigned voffA[2], voffB[2];
#pragma unroll
    for (int i = 0; i < 2; ++i) { int R, C; stage_rc(tid * 16 + i * 8192, R, C); const int Rb = (R & ~31) + perm32(R & 31);
        voffA[i] = (unsigned)(R * g.lda + C) * 2u; voffB[i] = (unsigned)(Rb * g.ldb + C) * 2u; }
    const size_t kstep = (size_t)(BK * 2);
    const size_t hstepA = (size_t)HALF * g.lda * 2, hstepB = (size_t)HALF * g.ldb * 2;
    const unsigned ldsw = (unsigned)wid * 1024u;
    const int aoff = lds_byte(wr * 64 + fr, fq * 8), boff = lds_byte(wc * 32 + fr, fq * 8);
#define PG8_SA(b, h) (((b) * 2 + (h)) * HTB)
#define PG8_SB(b, h) ((4 + (b) * 2 + (h)) * HTB)
#define PG8_STAGE(bufoff, gbase, voff) do { _Pragma("unroll") for (int _i = 0; _i < 2; ++_i) \
        __builtin_amdgcn_global_load_lds((const unsigned*)((const char*)(gbase) + (voff)[_i]), (LAS unsigned*)(lds + (bufoff) + ldsw + _i * 8192), 16, 0, 0); } while (0)
#define PG8_LDA(dst, b, h) do { _Pragma("unroll") for (int m = 0; m < 4; ++m) _Pragma("unroll") for (int k = 0; k < 2; ++k) dst[m][k] = *(const LAS bf16x8*)(lds + PG8_SA(b, h) + aoff + m * 2048 + k * 1024); } while (0)
#define PG8_LDB(dst, b, h) do { _Pragma("unroll") for (int n = 0; n < 2; ++n) _Pragma("unroll") for (int k = 0; k < 2; ++k) dst[n][k] = *(const LAS bf16x8*)(lds + PG8_SB(b, h) + boff + n * 2048 + k * 1024); } while (0)
#define PG8_MMA(ai, bj, At, Bt) do { __builtin_amdgcn_s_setprio(1); _Pragma("unroll") for (int m = 0; m < 4; ++m) _Pragma("unroll") for (int n = 0; n < 2; ++n) _Pragma("unroll") for (int k = 0; k < 2; ++k) \
        acc[ai][bj][m][n] = __builtin_amdgcn_mfma_f32_16x16x32_bf16(Bt[n][k], At[m][k], acc[ai][bj][m][n], 0, 0, 0); __builtin_amdgcn_s_setprio(0); } while (0)
#define PG8_WAIT_V(n) asm volatile("s_waitcnt vmcnt(" #n ")" ::: "memory")
#define PG8_WAIT_L(n) asm volatile("s_waitcnt lgkmcnt(" #n ")" ::: "memory")
#define PG8_BAR __builtin_amdgcn_s_barrier()
#define PG8_SCHED __builtin_amdgcn_sched_barrier(0)
    Unit cur, nxt; int ui = 0;
    if (!S.next(0, cur)) return;
    f32x4 acc[2][2][4][2];
#pragma unroll
    for (int a = 0; a < 2; ++a)
#pragma unroll
        for (int b = 0; b < 2; ++b)
#pragma unroll
            for (int m = 0; m < 4; ++m)
#pragma unroll
                for (int n = 0; n < 2; ++n) acc[a][b][m][n] = (f32x4){0.f, 0.f, 0.f, 0.f};
    bf16x8 At[4][2], B0[2][2], B1[2][2];
    const char* cA = S.opA(cur); const char* cB = S.opB(cur);
    PG8_STAGE(PG8_SB(0, 0), cB, voffB); PG8_STAGE(PG8_SB(0, 1), cB + hstepB, voffB); PG8_STAGE(PG8_SA(0, 0), cA, voffA); PG8_STAGE(PG8_SA(0, 1), cA + hstepA, voffA);
    if (wr == 1) PG8_BAR;
    PG8_WAIT_V(2); PG8_BAR;
    PG8_STAGE(PG8_SB(1, 0), cB + kstep, voffB); PG8_STAGE(PG8_SA(1, 0), cA + kstep, voffA); PG8_STAGE(PG8_SB(1, 1), cB + hstepB + kstep, voffB);
    PG8_WAIT_V(6); PG8_BAR;
    for (;;) {
        const bool has_next = S.next(ui + 1, nxt);
        const char* nA = has_next ? S.opA(nxt) : cA; const char* nB = has_next ? S.opB(nxt) : cB;
        for (int t = 0; t < nt; t += 2) {
            const bool last = (t == nt - 2);
            const char* a1 = cA + (size_t)(t + 1) * kstep;
            const char* a2 = last ? nA : cA + (size_t)(t + 2) * kstep; const char* b2 = last ? nB : cB + (size_t)(t + 2) * kstep;
            const char* a3 = a2 + kstep; const char* b3 = b2 + kstep;
            if constexpr (Epi::MID_T >= 0) { if (t == Epi::MID_T) E.mid(acc, cur, wr, wc, fr, fq); }
            PG8_LDB(B0, 0, 0); PG8_LDB(B1, 0, 1); PG8_SCHED; PG8_LDA(At, 0, 0); PG8_STAGE(PG8_SA(1, 1), a1 + hstepA, voffA);
            PG8_WAIT_V(8); PG8_WAIT_L(0); PG8_BAR; PG8_MMA(0, 0, At, B0); PG8_MMA(0, 1, At, B1); PG8_BAR; PG8_SCHED;
            PG8_LDA(At, 0, 1); PG8_STAGE(PG8_SB(0, 0), b2, voffB); PG8_STAGE(PG8_SB(0, 1), b2 + hstepB, voffB); PG8_STAGE(PG8_SA(0, 0), a2, voffA);
            PG8_WAIT_V(8); PG8_WAIT_L(0); PG8_BAR; PG8_MMA(1, 0, At, B0); PG8_MMA(1, 1, At, B1); PG8_BAR; PG8_SCHED;
            PG8_LDB(B0, 1, 0); PG8_LDB(B1, 1, 1); PG8_SCHED; PG8_LDA(At, 1, 0); PG8_STAGE(PG8_SA(0, 1), a2 + hstepA, voffA);
            PG8_WAIT_V(8); PG8_WAIT_L(0); PG8_BAR; PG8_MMA(0, 0, At, B0); PG8_MMA(0, 1, At, B1); PG8_BAR; PG8_SCHED;
            PG8_LDA(At, 1, 1); PG8_STAGE(PG8_SB(1, 0), b3, voffB); PG8_STAGE(PG8_SB(1, 1), b3 + hstepB, voffB); PG8_STAGE(PG8_SA(1, 0), a3, voffA);
            PG8_WAIT_V(8); PG8_WAIT_L(0); PG8_BAR; PG8_MMA(1, 0, At, B0); PG8_MMA(1, 1, At, B1); PG8_BAR; PG8_SCHED;
        }
        if constexpr (ALIGN_EPI) { if (wr == 0) PG8_BAR; }
        if constexpr (!Epi::AFTER_DRAIN) { E(acc, cur, wr, wc, fr, fq); }
        if (!has_next) break;
#pragma unroll
        for (int a = 0; a < 2; ++a)
#pragma unroll
            for (int b = 0; b < 2; ++b)
#pragma unroll
                for (int m = 0; m < 4; ++m)
#pragma unroll
                    for (int n = 0; n < 2; ++n) acc[a][b][m][n] = (f32x4){0.f, 0.f, 0.f, 0.f};
        cur = nxt; cA = nA; cB = nB; ++ui;
        if constexpr (ALIGN_EPI) { if (wr == 1) PG8_BAR; }
    }
    PG8_WAIT_V(0);
    if constexpr (!ALIGN_EPI) { if (wr == 0) PG8_BAR; }
    PG8_BAR;
    if constexpr (Epi::AFTER_DRAIN) { E.fused(acc, cur, wr, wc, fr, fq, lds, wid, lane); }
#undef PG8_SA
#undef PG8_SB
#undef PG8_STAGE
#undef PG8_LDA
#undef PG8_LDB
#undef PG8_MMA
#undef PG8_WAIT_V
#undef PG8_WAIT_L
#undef PG8_BAR
#undef PG8_SCHED
}
}
using pg8::Unit;
typedef f32x4 Acc[2][2][4][2];

struct SchedPlain {
    pg8::TileOrder T; const char* A; const char* Bt; size_t tA, tB;
    __device__ __forceinline__ bool next(int i, Unit& u) const { return T.tile(i, u); }
    __device__ __forceinline__ const char* opA(const Unit& u) const { return A + (size_t)(u.pm >> 3) * SLAB + (size_t)(u.pm & 7) * tA; }
    __device__ __forceinline__ const char* opB(const Unit& u) const { return Bt + (size_t)u.pn * tB; }
};
struct SchedWin {
    pg8::TileOrder T; const char* X; const char* W; size_t tX, tW;
    __device__ __forceinline__ bool next(int i, Unit& u) const { return T.tile(i, u); }
    __device__ __forceinline__ const char* xp(const Unit& u) const { return X + (size_t)(u.pm >> 3) * SLAB + (size_t)(u.pm & 7) * tX; }
    __device__ __forceinline__ const char* opA(const Unit& u) const { return (u.pn == 3 || u.pn == 4) ? W + (size_t)u.pn * tW : xp(u); }
    __device__ __forceinline__ const char* opB(const Unit& u) const { return (u.pn == 3 || u.pn == 4) ? xp(u) : W + (size_t)u.pn * tW; }
};
struct SchedOne {
    const char* A; const char* Bt; Unit u0;
    __device__ __forceinline__ bool next(int i, Unit& u) const { if (i > 0) return false; u = u0; return true; }
    __device__ __forceinline__ const char* opA(const Unit&) const { return A; }
    __device__ __forceinline__ const char* opB(const Unit&) const { return Bt; }
};

struct SchedDft {
    const char* A; const char* FTb; int pmT;
    __device__ __forceinline__ bool next(int i, Unit& u) const { if (i > 1) return false; u.pm = pmT; u.pn = i; return true; }
    __device__ __forceinline__ const char* opA(const Unit&) const { return A; }
    __device__ __forceinline__ const char* opB(const Unit& u) const { return FTb + (size_t)u.pn * 256 * SEQ * 2; }
};

struct EpiSwiGLU {
    static constexpr bool AFTER_DRAIN = false; static constexpr int MID_T = -1;
    const float* RS; bf16_t* O;
    __device__ __forceinline__ void mid(Acc&, const Unit&, int, int, int, int) const {}
    __device__ __forceinline__ void operator()(const Acc& acc, const Unit& u, int wr, int wc, int fr, int fq) const {
        asm volatile("" : "+v"(fr), "+v"(fq));
        const int row0 = u.pm * 256 + wr * 64 + fr, col0 = u.pn * 128 + wc * 32 + 8 * fq;
        float rv[2][4];
#pragma unroll
        for (int ai = 0; ai < 2; ++ai)
#pragma unroll
            for (int m = 0; m < 4; ++m) rv[ai][m] = row_rinv(RS, row0 + ai * 128 + m * 16);
#pragma unroll
        for (int ai = 0; ai < 2; ++ai)
#pragma unroll
            for (int m = 0; m < 4; ++m) {
                const int row = row0 + ai * 128 + m * 16; const float r = rv[ai][m];
                f32x4 o[2];
#pragma unroll
                for (int n = 0; n < 2; ++n) { const f32x4 g = acc[ai][0][m][n] * r, up = acc[ai][1][m][n] * r;
#pragma unroll
                    for (int j = 0; j < 4; ++j) { const float e = __builtin_amdgcn_exp2f(-g[j] * LOG2E); o[n][j] = g[j] * up[j] * __builtin_amdgcn_rcpf(1.0f + e); } }
                st16(brow(O, row, DFF) + col0, pack8(o[0], o[1]));
            }
    }
};
template <bool XIN_F32> struct EpiResid {
    static constexpr bool AFTER_DRAIN = true; static constexpr int MID_T = -1;
    const float* xin; bf16_t* XB; float* RSo; float alpha;
    __device__ __forceinline__ void mid(Acc&, const Unit&, int, int, int, int) const {}
    __device__ __forceinline__ void operator()(const Acc&, const Unit&, int, int, int, int) const {}
    __device__ __forceinline__ void fused(Acc& acc, const Unit& u, int wr, int wc, int fr, int fq, LAS unsigned char* lds, int wid, int lane) const {
        asm volatile("" : "+v"(fr), "+v"(fq));
        LAS float* P = (LAS float*)lds;
#pragma unroll
        for (int ai = 0; ai < 2; ++ai) {
            u32x4 xr[4][2]; f32x4 xf[2][2][2];
            if constexpr (!XIN_F32) {
#pragma unroll
                for (int m = 0; m < 4; ++m)
#pragma unroll
                    for (int bj = 0; bj < 2; ++bj) xr[m][bj] = *(const u32x4*)(brow(XB, u.pm * 256 + ai * 128 + wr * 64 + m * 16 + fr, DM) + u.pn * 256 + bj * 128 + wc * 32 + 8 * fq);
            }
#pragma unroll
            for (int m = 0; m < 4; ++m) {
                const int rl = ai * 128 + wr * 64 + m * 16 + fr, row = u.pm * 256 + rl; float ss = 0.f;
                if constexpr (XIN_F32) { if ((m & 1) == 0) {
#pragma unroll
                    for (int mm = 0; mm < 2; ++mm)
#pragma unroll
                        for (int bj = 0; bj < 2; ++bj) { const size_t off = (size_t)(row + 16 * mm) * DM + u.pn * 256 + bj * 128 + wc * 32 + 8 * fq; xf[mm][bj][0] = *(const f32x4*)(xin + off); xf[mm][bj][1] = *(const f32x4*)(xin + off + 4); } } }
#pragma unroll
                for (int bj = 0; bj < 2; ++bj) {
                    const int col = u.pn * 256 + bj * 128 + wc * 32 + 8 * fq;
                    bf16_t* xb = brow(XB, row, DM) + col;
                    f32x4 x0, x1;
                    if constexpr (XIN_F32) { x0 = xf[m & 1][bj][0]; x1 = xf[m & 1][bj][1]; }
                    else unpack8(xr[m][bj], x0, x1);
                    x0 = x0 + acc[ai][bj][m][0] * alpha; x1 = x1 + acc[ai][bj][m][1] * alpha;
                    ss += (x0[0] * x0[0] + x0[1] * x0[1]) + (x0[2] * x0[2] + x0[3] * x0[3]) + (x1[0] * x1[0] + x1[1] * x1[1]) + (x1[2] * x1[2] + x1[3] * x1[3]);
                    st16(xb, pack8(x0, x1));
                }
                ss += __shfl_xor(ss, 16); ss += __shfl_xor(ss, 32);
                if (fq == 0) P[rl * 4 + wc] = ss;
            }
        }
        asm volatile("s_waitcnt lgkmcnt(0)" ::: "memory"); __builtin_amdgcn_s_barrier(); asm volatile("" ::: "memory");
        const int tid = wid * 64 + lane;
        if (tid < 256) { const f32x4 p = *(const LAS f32x4*)(P + tid * 4); RSo[(size_t)(u.pm * 256 + tid) * 4 + u.pn] = (p[0] + p[1]) + (p[2] + p[3]); }
    }
};
struct EpiWin {
    static constexpr bool AFTER_DRAIN = false; static constexpr int MID_T = -1;
    const float* RS; const float* bg; bf16_t* QKV; bf16_t* FT; bf16_t* GATES;
    __device__ __forceinline__ void mid(Acc&, const Unit&, int, int, int, int) const {}
    __device__ __forceinline__ void operator()(const Acc& acc, const Unit& u, int wr, int wc, int fr, int fq) const {
        asm volatile("" : "+v"(fr), "+v"(fq));
        if (u.pn < 3) {
            const int row0 = u.pm * 256 + wr * 64 + fr, col0 = u.pn * 256 + wc * 32 + 8 * fq;
            float rv[2][4];
#pragma unroll
            for (int ai = 0; ai < 2; ++ai)
#pragma unroll
                for (int m = 0; m < 4; ++m) rv[ai][m] = row_rinv(RS, row0 + ai * 128 + m * 16);
#pragma unroll
            for (int ai = 0; ai < 2; ++ai)
#pragma unroll
                for (int m = 0; m < 4; ++m) { const int row = row0 + ai * 128 + m * 16; const float r = rv[ai][m];
#pragma unroll
                    for (int bj = 0; bj < 2; ++bj) st16(brow(QKV, row, 768) + col0 + bj * 128, pack8(acc[ai][bj][m][0] * r, acc[ai][bj][m][1] * r)); }
        } else if (u.pn < 5) {
            f32x4 rt[2][2];
#pragma unroll
            for (int bj = 0; bj < 2; ++bj)
#pragma unroll
                for (int n = 0; n < 2; ++n)
#pragma unroll
                    for (int j = 0; j < 4; ++j) rt[bj][n][j] = row_rinv(RS, u.pm * 256 + bj * 128 + wc * 32 + 8 * fq + 4 * n + j);
            const int b = u.pm >> 3, s0 = (u.pm & 7) * 256 + wc * 32 + 8 * fq;
#pragma unroll
            for (int ai = 0; ai < 2; ++ai)
#pragma unroll
                for (int m = 0; m < 4; ++m) { const int ch = (u.pn - 3) * 256 + ai * 128 + wr * 64 + m * 16 + fr; bf16_t* base = FT + (size_t)b * SLAB_E + (size_t)ch * SEQ + s0;
#pragma unroll
                    for (int bj = 0; bj < 2; ++bj) st16(base + bj * 128, pack8(acc[ai][bj][m][0] * rt[bj][0], acc[ai][bj][m][1] * rt[bj][1])); }
        } else {
            const int c0 = (u.pn - 5) * 128 + wc * 32 + 8 * fq, row0 = u.pm * 256 + wr * 64 + fr;
            f32x4 ba[2], bb[2];
#pragma unroll
            for (int n = 0; n < 2; ++n) { ba[n] = *(const f32x4*)(bg + c0 + 4 * n); bb[n] = *(const f32x4*)(bg + DM + c0 + 4 * n); }
            float rv[2][4];
#pragma unroll
            for (int ai = 0; ai < 2; ++ai)
#pragma unroll
                for (int m = 0; m < 4; ++m) rv[ai][m] = row_rinv(RS, row0 + ai * 128 + m * 16);
#pragma unroll
            for (int ai = 0; ai < 2; ++ai)
#pragma unroll
                for (int m = 0; m < 4; ++m) { const int row = row0 + ai * 128 + m * 16; const float r = rv[ai][m];
                    f32x4 ra[2], gb[2];
#pragma unroll
                    for (int n = 0; n < 2; ++n) { const f32x4 za = acc[ai][0][m][n] * r + ba[n], zb = acc[ai][1][m][n] * r + bb[n];
#pragma unroll
                        for (int j = 0; j < 4; ++j) { const float ea = __builtin_amdgcn_exp2f(-za[j] * LOG2E), eb = __builtin_amdgcn_exp2f(-zb[j] * LOG2E);
                            ra[n][j] = (1.0f + eb) * __builtin_amdgcn_rcpf(1.0f + ea); gb[n][j] = __builtin_amdgcn_rcpf(1.0f + eb); } }
                    bf16_t* gp = brow(GATES, row, 2048) + c0; st16(gp, pack8(ra[0], ra[1])); st16(gp + DM, pack8(gb[0], gb[1])); }
        }
    }
};
struct EpiDft {
    static constexpr bool AFTER_DRAIN = false; static constexpr int MID_T = -1;
    bf16_t* AOPQ; int b;
    __device__ __forceinline__ void mid(Acc&, const Unit&, int, int, int, int) const {}
    __device__ __forceinline__ void operator()(const Acc& acc, const Unit& u, int wr, int wc, int fr, int fq) const {
        asm volatile("" : "+v"(fr), "+v"(fq));
        const int part = u.pm >> 2, k0 = (u.pm & 3) * 256 + wr * 64 + fr;
        bf16_t* ab = AOPQ + (size_t)b * SLAB_E + 512 + wc * 32 + 8 * fq;
#pragma unroll
        for (int ai = 0; ai < 2; ++ai)
#pragma unroll
            for (int m = 0; m < 4; ++m) { const int k = k0 + ai * 128 + m * 16;
#pragma unroll
                for (int bj = 0; bj < 2; ++bj) { const int cg = (u.pn * 2 + bj) * 256; const f32x4 v0 = acc[ai][bj][m][0], v1 = acc[ai][bj][m][1];
                    if (part == 0) { const u32x4 w = pack8(v0, v1); st16(ab + (size_t)k * KAB + cg, w); if (k != 0) st16(ab + (size_t)(SEQ - k) * KAB + cg, w); }
                    else if (k != 0) { st16(ab + (size_t)k * KAB + cg + 128, pack8(v0, v1)); st16(ab + (size_t)(SEQ - k) * KAB + cg + 128, pack8(-v0, -v1)); }
                    else { const u32x4 z = (u32x4){0u, 0u, 0u, 0u}; st16(ab + (size_t)1024 * KAB + cg, pack8(v0, v1)); st16(ab + cg + 128, z); st16(ab + (size_t)1024 * KAB + cg + 128, z); } } }
    }
};
struct EpiGate {
    static constexpr bool AFTER_DRAIN = false; static constexpr int MID_T = 8;
    bf16_t* GATES;
    __device__ __forceinline__ void scale(Acc& acc, const Unit& u, int wr, int wc, int fr, int fq, int goff) const {
        asm volatile("" : "+v"(fr), "+v"(fq));
        u32x4 w[2][4][2];
#pragma unroll
        for (int ai = 0; ai < 2; ++ai)
#pragma unroll
            for (int m = 0; m < 4; ++m)
#pragma unroll
                for (int bj = 0; bj < 2; ++bj) w[ai][m][bj] = *(const u32x4*)(brow(GATES, u.pm * 256 + ai * 128 + wr * 64 + m * 16 + fr, 2048) + goff + u.pn * 256 + bj * 128 + wc * 32 + 8 * fq);
#pragma unroll
        for (int ai = 0; ai < 2; ++ai)
#pragma unroll
            for (int m = 0; m < 4; ++m)
#pragma unroll
                for (int bj = 0; bj < 2; ++bj) { f32x4 s0, s1; unpack8(w[ai][m][bj], s0, s1);
                    acc[ai][bj][m][0] = acc[ai][bj][m][0] * s0; acc[ai][bj][m][1] = acc[ai][bj][m][1] * s1; }
    }
    __device__ __forceinline__ void mid(Acc& acc, const Unit& u, int wr, int wc, int fr, int fq) const { scale(acc, u, wr, wc, fr, fq, 0); }
    __device__ __forceinline__ void operator()(Acc& acc, const Unit& u, int wr, int wc, int fr, int fq) const {
        scale(acc, u, wr, wc, fr, fq, DM);
#pragma unroll
        for (int ai = 0; ai < 2; ++ai)
#pragma unroll
            for (int m = 0; m < 4; ++m) { const int row = u.pm * 256 + ai * 128 + wr * 64 + m * 16 + fr;
#pragma unroll
                for (int bj = 0; bj < 2; ++bj) st16(brow(GATES, row, 2048) + u.pn * 256 + bj * 128 + wc * 32 + 8 * fq, pack8(acc[ai][bj][m][0], acc[ai][bj][m][1])); }
    }
};

namespace att {
constexpr int LDS_K = 0, LDS_V = 49152, LDS_OST = 98304;
__device__ __forceinline__ int crow(int r, int hi) { return (r & 3) + 8 * (r >> 2) + 4 * hi; }
__device__ __forceinline__ int t5_bucket(int rel) {
    const int n = rel < 0 ? -rel : rel; int b;
    if (n < 8) b = n; else if (n < 12) b = 8; else if (n < 16) b = 9; else if (n < 23) b = 10; else if (n < 32) b = 11; else if (n < 46) b = 12; else if (n < 64) b = 13; else if (n < 91) b = 14; else b = 15;
    return b + (rel > 0 ? 16 : 0);
}
__device__ __forceinline__ s16x4 vtr(const LAS unsigned char* p) { typedef short v4i16_t __attribute__((ext_vector_type(4))); return __builtin_bit_cast(s16x4, __builtin_amdgcn_ds_read_tr16_b64_v4i16((LAS v4i16_t*)p)); }
__device__ __forceinline__ unsigned short f2bf(float f) { unsigned u = __builtin_bit_cast(unsigned, f); return (unsigned short)((u + 0x7fffu + ((u >> 16) & 1u)) >> 16); }

__device__ __forceinline__ void attn_unit(LAS unsigned char* ring, LAS float* biasT  , LAS float* wsfAll  , const bf16_t* QKV, bf16_t* AOPQ,
                                          const float* sink, const float* relb, int b, int kvh, int n) {
    const int tid = threadIdx.x, lane = tid & 63, r32 = lane & 31, hi = lane >> 5, wid = __builtin_amdgcn_readfirstlane(tid >> 6);
    for (int t = tid; t < 4 * 257; t += 512) { const int g = t / 257, idx = t - g * 257; biasT[g * 260 + idx] = relb[t5_bucket(idx - 128) * 8 + kvh * 4 + g] * LOG2E; }
    const int tlo = (n == 0) ? 2 : 0, thi = (n == 15) ? 3 : 5;
    const size_t rowb = 0; QKV += (size_t)b * SLAB_E; AOPQ += (size_t)b * SLAB_E; const int key0 = 128 * (n - 1);
    for (int t = tlo; t <= thi; ++t) {
        const bf16_t* ks = QKV + (rowb + key0 + 64 * t + lane) * 768 + 512 + kvh * 64 + wid * 8;
        __builtin_amdgcn_global_load_lds((const unsigned*)ks, (LAS unsigned*)(ring + LDS_K + t * 8192 + wid * 1024), 16, 0, 0);
        const bf16_t* vs = QKV + (rowb + key0 + 64 * t + 16 * (wid & 3) + (lane >> 2)) * 768 + 640 + kvh * 64 + (wid >> 2) * 32 + (lane & 3) * 8;
        __builtin_amdgcn_global_load_lds((const unsigned*)vs, (LAS unsigned*)(ring + LDS_V + t * 8192 + wid * 1024), 16, 0, 0);
    }
    asm volatile("s_waitcnt vmcnt(0) lgkmcnt(0)" ::: "memory"); __builtin_amdgcn_s_barrier(); asm volatile("" ::: "memory");
    const int g = wid >> 1, h = kvh * 4 + g;
    LAS float* wsf = wsfAll + wid * 64; const LAS float* bT = biasT + g * 260;
    const float sinkl = sink[h] * LOG2E;
    for (int qq = 0; qq < 2; ++qq) {
        const int q0 = (wid & 1) * 64 + 32 * qq, qpos = 128 + q0 + r32;
        const bf16_t* qp = QKV + (rowb + 128 * n + q0 + r32) * 768 + h * 64 + hi * 8;
        bf16x8 qr[4];
#pragma unroll
        for (int d0 = 0; d0 < 4; ++d0) qr[d0] = *(const bf16x8*)(qp + d0 * 16);
        float m_run = sinkl, l_run = hi ? 0.f : 1.f;
        f32x16 o0, o1;
#pragma unroll
        for (int r = 0; r < 16; ++r) { o0[r] = 0.f; o1[r] = 0.f; }
        int t0 = q0 >> 6, t1 = (287 + q0) >> 6; t0 = t0 < tlo ? tlo : t0; t1 = t1 > thi ? thi : t1;
        for (int t = t0; t <= t1; ++t) {
            f32x16 p0, p1;
#pragma unroll
            for (int r = 0; r < 16; ++r) { p0[r] = 0.f; p1[r] = 0.f; }
            const LAS unsigned char* kb = ring + LDS_K + t * 8192 + hi * 1024 + r32 * 16;
#pragma unroll
            for (int d0 = 0; d0 < 4; ++d0) { const bf16x8 k0 = *(const LAS bf16x8*)(kb + d0 * 2048), k1 = *(const LAS bf16x8*)(kb + d0 * 2048 + 512);
                p0 = __builtin_amdgcn_mfma_f32_32x32x16_bf16(k0, qr[d0], p0, 0, 0, 0); p1 = __builtin_amdgcn_mfma_f32_32x32x16_bf16(k1, qr[d0], p1, 0, 0, 0); }
            const int base = 64 * t - qpos + 128;
            float tm = -INFINITY;
#pragma unroll
            for (int r = 0; r < 16; ++r) { const int i0 = base + crow(r, hi), i1 = i0 + 32;
                const int c0 = i0 < 0 ? 0 : (i0 > 256 ? 256 : i0), c1 = i1 < 0 ? 0 : (i1 > 256 ? 256 : i1);
                const float b0 = bT[c0], b1 = bT[c1];
                p0[r] = (i0 >= 0 && i0 <= 256) ? p0[r] + b0 : -INFINITY; p1[r] = (i1 >= 0 && i1 <= 256) ? p1[r] + b1 : -INFINITY;
                tm = fmaxf(tm, fmaxf(p0[r], p1[r])); }
            tm = fmaxf(tm, __shfl_xor(tm, 32));
            const float mn = fmaxf(m_run, tm), alpha = __builtin_amdgcn_exp2f(m_run - mn); m_run = mn;
            float rs = 0.f;
#pragma unroll
            for (int r = 0; r < 16; ++r) { p0[r] = __builtin_amdgcn_exp2f(p0[r] - mn); p1[r] = __builtin_amdgcn_exp2f(p1[r] - mn); rs += p0[r] + p1[r]; }
            l_run = l_run * alpha + rs;
            if (hi == 0) wsf[r32] = alpha;
            asm volatile("s_waitcnt lgkmcnt(0)" ::: "memory");
#pragma unroll
            for (int r = 0; r < 16; ++r) { const float a = wsf[crow(r, hi)]; o0[r] *= a; o1[r] *= a; }
            u32x4 pw[4];
            pw[0] = (u32x4){cvtpk(p0[0], p0[1]), cvtpk(p0[2], p0[3]), cvtpk(p0[4], p0[5]), cvtpk(p0[6], p0[7])};
            pw[1] = (u32x4){cvtpk(p0[8], p0[9]), cvtpk(p0[10], p0[11]), cvtpk(p0[12], p0[13]), cvtpk(p0[14], p0[15])};
            pw[2] = (u32x4){cvtpk(p1[0], p1[1]), cvtpk(p1[2], p1[3]), cvtpk(p1[4], p1[5]), cvtpk(p1[6], p1[7])};
            pw[3] = (u32x4){cvtpk(p1[8], p1[9]), cvtpk(p1[10], p1[11]), cvtpk(p1[12], p1[13]), cvtpk(p1[14], p1[15])};
            const LAS unsigned char* vb = ring + LDS_V + t * 8192 + ((lane >> 4) & 1) * 32 + (lane & 3) * 8 + (4 * hi + ((lane & 15) >> 2)) * 64;
#pragma unroll
            for (int ks = 0; ks < 4; ++ks) {
                const s16x4 l0 = vtr(vb + ks * 1024), h0 = vtr(vb + ks * 1024 + 512), l1 = vtr(vb + 4096 + ks * 1024), h1 = vtr(vb + 4096 + ks * 1024 + 512);
                const bf16x8 v0 = (bf16x8){l0[0], l0[1], l0[2], l0[3], h0[0], h0[1], h0[2], h0[3]}, v1 = (bf16x8){l1[0], l1[1], l1[2], l1[3], h1[0], h1[1], h1[2], h1[3]};
                const bf16x8 pa = __builtin_bit_cast(bf16x8, pw[ks]);
                o0 = __builtin_amdgcn_mfma_f32_32x32x16_bf16(pa, v0, o0, 0, 0, 0); o1 = __builtin_amdgcn_mfma_f32_32x32x16_bf16(pa, v1, o1, 0, 0, 0);
            }
        }
        const float lt = l_run + __shfl_xor(l_run, 32);
        if (hi == 0) wsf[32 + r32] = lt;
        asm volatile("s_waitcnt lgkmcnt(0)" ::: "memory");
        LAS unsigned short* stg = (LAS unsigned short*)(ring + LDS_OST + wid * 4096);
#pragma unroll
        for (int r = 0; r < 16; ++r) { const int orow = crow(r, hi); const float rli = __builtin_amdgcn_rcpf(wsf[32 + orow]);
            stg[orow * 64 + r32] = f2bf(o0[r] * rli); stg[orow * 64 + 32 + r32] = f2bf(o1[r] * rli); }
        asm volatile("s_waitcnt lgkmcnt(0)" ::: "memory");
#pragma unroll
        for (int i = 0; i < 4; ++i) { const int row = i * 8 + (lane >> 3), ch = lane & 7; const u32x4 v = *(const LAS u32x4*)(stg + row * 64 + ch * 8);
            st16(AOPQ + (rowb + 128 * n + q0 + row) * KAB + h * 64 + ch * 8, v); }
        asm volatile("s_waitcnt lgkmcnt(0)" ::: "memory");
    }
}
}

constexpr size_t MiB = 1u << 20;
constexpr size_t WS_CTL = 0, CTL_ZERO_BYTES = 64 * 1024;
constexpr size_t WS_RS = 256 * 1024;
constexpr size_t RS_BYTES = (size_t)MTOK * 4 * 4;
constexpr size_t WS_WUP1 = 2 * MiB;
constexpr size_t WS_WDN1 = WS_WUP1 + 11 * MiB;
constexpr size_t WS_WIN = WS_WDN1 + 11 * MiB / 2;
constexpr size_t WS_WAB = WS_WIN + 13 * MiB / 2;
constexpr size_t WS_WO = WS_WAB + 3 * MiB;
constexpr size_t WS_WUP2 = WS_WO + 2 * MiB;
constexpr size_t WS_WDN2 = WS_WUP2 + 11 * MiB;
constexpr size_t WS_TM = WS_WDN2 + 11 * MiB / 2;
constexpr size_t WS_SLAB0 = WS_TM + 16 * MiB;
constexpr size_t WS_XB = WS_SLAB0, WS_AFF = WS_SLAB0 + 4 * MiB, WS_QKV = WS_SLAB0 + 4 * MiB, WS_FT = WS_SLAB0 + 7 * MiB, WS_GATES = WS_SLAB0 + 9 * MiB, WS_AOPQ = WS_SLAB0 + 17 * MiB;
constexpr size_t WS_END = WS_SLAB0 + 8 * SLAB;
static_assert(WS_END <= 256 * MiB && WS_RS + 4 * RS_BYTES <= WS_WUP1, "d_ws map");
static_assert((size_t)SEQ * DM * 2 == 4 * MiB && (size_t)SEQ * DFF * 2 == 11 * MiB && (size_t)SEQ * 768 * 2 == 3 * MiB && (size_t)512 * SEQ * 2 == 2 * MiB && (size_t)SEQ * 2048 * 2 == 8 * MiB && (size_t)SEQ * KAB * 2 == 6 * MiB, "slab pieces");

constexpr int RING_BYTES = 131072, LDSCTL_OFF = RING_BYTES, MISC_OFF = LDSCTL_OFF + 320, BIAS_OFF = LDSCTL_OFF + 512, WSF_OFF = BIAS_OFF + 4 * 260 * 4, LDS_BYTES = 147456;
static_assert(WSF_OFF + 8 * 64 * 4 <= LDS_BYTES, "LDS map");

#define XB_TMO      128
#define XB_XCNT(j)  (256  + 64 * (j))
#define XB_XSUB(j)  (1280 + 64 * (j))
#define XB_XGEN(j)  (2304 + 64 * (j))
#define XB_TOP      3328
#define XB_TOPGEN   3392
#define XCD_BAR_WORDS 3456
#define XB_SPIN_CAP (1u << 18)
__device__ __forceinline__ unsigned xb_ld(unsigned* p)              { return __hip_atomic_load(p, __ATOMIC_RELAXED, __HIP_MEMORY_SCOPE_AGENT); }
__device__ __forceinline__ unsigned xb_add(unsigned* p, unsigned v) { return __hip_atomic_fetch_add(p, v, __ATOMIC_RELAXED, __HIP_MEMORY_SCOPE_AGENT); }
__device__ __forceinline__ unsigned xb_xcc_id() { return (unsigned)__builtin_amdgcn_s_getreg((3 << 11) | 20) & 0xFu; }
#define XB_SPIN(cond, bar) do { unsigned _sp = 0; while (cond) { __builtin_amdgcn_s_sleep(1); \
    if ((++_sp & 255u) == 0u) { if (xb_ld(&(bar)[XB_TMO])) break; if (_sp > XB_SPIN_CAP) { atomicAdd(&(bar)[XB_TMO], 1u); break; } } } } while (0)
struct XcdBarrier { unsigned* bar; unsigned x; volatile LAS unsigned* st; };
__device__ __forceinline__ XcdBarrier xcd_barrier_post(unsigned* bar, volatile LAS unsigned* st) {
    XcdBarrier b; b.bar = bar; b.x = xb_xcc_id(); b.st = st;
    if (threadIdx.x == 0) (void)xb_add(&bar[XB_XCNT(b.x)], 1u);
    return b;
}
__device__ __forceinline__ void xcd_barrier_complete(unsigned* bar, unsigned x, unsigned& nloc, unsigned& nx) {
    const unsigned G = gridDim.x * gridDim.y * gridDim.z;
    unsigned sum, cnt, mine, sp = 0u;
    for (;;) {
        sum = 0u; cnt = 0u; mine = 0u;
#pragma unroll
        for (unsigned j = 0; j < 16; ++j) { const unsigned c = xb_ld(&bar[XB_XCNT(j)]); sum += c; cnt += (c > 0u) ? 1u : 0u; mine = (j == x) ? c : mine; }
        if (sum == G) break;
        __builtin_amdgcn_s_sleep(1);
        if ((++sp & 255u) == 0u) { if (xb_ld(&bar[XB_TMO])) break; if (sp > XB_SPIN_CAP) { atomicAdd(&bar[XB_TMO], 1u); break; } }
    }
    nloc = mine > 0u ? mine : 1u; nx = cnt > 0u ? cnt : 1u;
}
__device__ __forceinline__ void xcd_barrier(const XcdBarrier& b) {
    asm volatile("s_waitcnt vmcnt(0)" ::: "memory");
    __syncthreads();
    if (threadIdx.x == 0) {
        unsigned* bar = b.bar;
        __builtin_amdgcn_s_waitcnt(0);
        unsigned nloc = b.st[0], nx = b.st[1];
        if (nloc == 0u) { xcd_barrier_complete(bar, b.x, nloc, nx); b.st[0] = nloc; b.st[1] = nx; }
        const unsigned old = xb_add(&bar[XB_XSUB(b.x)], 1u);
        const unsigned gen = old / nloc;
        if (old + 1u == (gen + 1u) * nloc) {
            __builtin_amdgcn_fence(__ATOMIC_RELEASE, "agent");
            asm volatile("s_waitcnt vmcnt(0)" ::: "memory");
            const unsigned og = xb_add(&bar[XB_TOP], 1u);
            const unsigned tg = og / nx;
            if (og + 1u == (tg + 1u) * nx) xb_add(&bar[XB_TOPGEN], 1u);
            else XB_SPIN(xb_ld(&bar[XB_TOPGEN]) == tg, bar);
            __builtin_amdgcn_fence(__ATOMIC_ACQUIRE, "agent");
            xb_add(&bar[XB_XGEN(b.x)], 1u);
            asm volatile("s_waitcnt vmcnt(0)" ::: "memory");
        } else {
            XB_SPIN(xb_ld(&bar[XB_XGEN(b.x)]) == gen, bar);
            __builtin_amdgcn_fence(__ATOMIC_ACQUIRE, "agent");
            asm volatile("s_waitcnt vmcnt(0)" ::: "memory");
        }
    }
    __syncthreads();
}


__device__ __forceinline__ void group_barrier(unsigned* cnt, unsigned target, bool pure, unsigned* tmo) {
    asm volatile("s_waitcnt vmcnt(0)" ::: "memory");
    __syncthreads();
    if (threadIdx.x == 0) {
        if (!pure) { __builtin_amdgcn_fence(__ATOMIC_RELEASE, "agent"); asm volatile("s_waitcnt vmcnt(0)" ::: "memory"); }
        (void)xb_add(cnt, 1u);
        unsigned sp = 0u;
        while (xb_ld(cnt) < target) { __builtin_amdgcn_s_sleep(1); if ((++sp & 255u) == 0u) { if (xb_ld(tmo)) break; if (sp > XB_SPIN_CAP) { atomicAdd(tmo, 1u); break; } } }
        __builtin_amdgcn_fence(__ATOMIC_ACQUIRE, "agent");
        asm volatile("s_waitcnt vmcnt(0)" ::: "memory");
    }
    __syncthreads();
}


struct EpiFinal {
    static constexpr bool AFTER_DRAIN = true; static constexpr int MID_T = -1;
    const bf16_t* XB; float* out; float* RSo; const float* gfin; float alpha; unsigned* cnt; unsigned target; bool pure; unsigned* tmo;
    __device__ __forceinline__ void mid(Acc&, const Unit&, int, int, int, int) const {}
    __device__ __forceinline__ void operator()(const Acc&, const Unit&, int, int, int, int) const {}
    __device__ __forceinline__ void fused(Acc& acc, const Unit& u, int wr, int wc, int fr, int fq, LAS unsigned char* lds, int wid, int lane) const {
        asm volatile("" : "+v"(fr), "+v"(fq));
        LAS float* P = (LAS float*)lds;
#pragma unroll
        for (int ai = 0; ai < 2; ++ai) {
            u32x4 xr[4][2];
#pragma unroll
            for (int m = 0; m < 4; ++m)
#pragma unroll
                for (int bj = 0; bj < 2; ++bj) xr[m][bj] = *(const u32x4*)(brow(XB, u.pm * 256 + ai * 128 + wr * 64 + m * 16 + fr, DM) + u.pn * 256 + bj * 128 + wc * 32 + 8 * fq);
#pragma unroll
            for (int m = 0; m < 4; ++m) {
                const int rl = ai * 128 + wr * 64 + m * 16 + fr, row = u.pm * 256 + rl; float ss = 0.f;
#pragma unroll
                for (int bj = 0; bj < 2; ++bj) {
                    f32x4 x0, x1; unpack8(xr[m][bj], x0, x1);
                    x0 = x0 + acc[ai][bj][m][0] * alpha; x1 = x1 + acc[ai][bj][m][1] * alpha;
                    acc[ai][bj][m][0] = x0; acc[ai][bj][m][1] = x1;
                    ss += (x0[0] * x0[0] + x0[1] * x0[1]) + (x0[2] * x0[2] + x0[3] * x0[3]) + (x1[0] * x1[0] + x1[1] * x1[1]) + (x1[2] * x1[2] + x1[3] * x1[3]);
                }
                ss += __shfl_xor(ss, 16); ss += __shfl_xor(ss, 32);
                if (fq == 0) P[rl * 4 + wc] = ss;
            }
        }
        asm volatile("s_waitcnt lgkmcnt(0)" ::: "memory"); __builtin_amdgcn_s_barrier(); asm volatile("" ::: "memory");
        const int tid = wid * 64 + lane;
        if (tid < 256) { const f32x4 p = *(const LAS f32x4*)(P + tid * 4); RSo[(size_t)(u.pm * 256 + tid) * 4 + u.pn] = (p[0] + p[1]) + (p[2] + p[3]); }
        group_barrier(cnt, target, pure, tmo);
        asm volatile("" : "+v"(fr), "+v"(fq));
        f32x4 gv[2][2];
#pragma unroll
        for (int bj = 0; bj < 2; ++bj)
#pragma unroll
            for (int n = 0; n < 2; ++n) gv[bj][n] = *(const f32x4*)(gfin + u.pn * 256 + bj * 128 + wc * 32 + 8 * fq + 4 * n);
        float rv[2][4];
#pragma unroll
        for (int ai = 0; ai < 2; ++ai)
#pragma unroll
            for (int m = 0; m < 4; ++m) rv[ai][m] = row_rinv(RSo, u.pm * 256 + ai * 128 + wr * 64 + m * 16 + fr);
#pragma unroll
        for (int ai = 0; ai < 2; ++ai)
#pragma unroll
            for (int m = 0; m < 4; ++m) {
                const int row = u.pm * 256 + ai * 128 + wr * 64 + m * 16 + fr; const float r = rv[ai][m];
#pragma unroll
                for (int bj = 0; bj < 2; ++bj) { const size_t off = (size_t)row * DM + u.pn * 256 + bj * 128 + wc * 32 + 8 * fq;
                    st16f(out + off, acc[ai][bj][m][0] * gv[bj][0] * r); st16f(out + off + 4, acc[ai][bj][m][1] * gv[bj][1] * r); }
            }
    }
};

__device__ __forceinline__ float wave_sum(float v) {
#pragma unroll
    for (int o = 1; o < 64; o <<= 1) v += __shfl_xor(v, o);
    return v;
}
__device__ __forceinline__ void transpose_item(const float* W, int ldsrc, int srccol0, int k0, const float* gk, float cs, bf16_t* WT, int ldd, int drow0, LAS float* scr, int lane) {
#pragma unroll 8
    for (int i = 0; i < 32; ++i) { const int kk = 2 * i + (lane >> 5); float v = W[(size_t)(k0 + kk) * ldsrc + srccol0 + (lane & 31)]; if (gk) v *= gk[k0 + kk]; scr[kk * 33 + (lane & 31)] = v * cs; }
    asm volatile("s_waitcnt lgkmcnt(0)" ::: "memory");
    const int c = lane & 7;
#pragma unroll
    for (int j = 0; j < 4; ++j) { const int n = (lane >> 3) + 8 * j; const LAS float* s = scr + (8 * c) * 33 + n;
        u32x4 o; o.x = cvtpk(s[0 * 33], s[1 * 33]); o.y = cvtpk(s[2 * 33], s[3 * 33]); o.z = cvtpk(s[4 * 33], s[5 * 33]); o.w = cvtpk(s[6 * 33], s[7 * 33]);
        *(u32x4*)(WT + (size_t)(drow0 + n) * ldd + k0 + 8 * c) = o; }
    asm volatile("s_waitcnt lgkmcnt(0)" ::: "memory");
}
__device__ __forceinline__ int map_up(int rho) { const int pn = rho >> 8, i = rho & 255; return i < 128 ? 128 * pn + i : DFF + 128 * pn + (i - 128); }
__device__ __forceinline__ int map_in(int rho) { if (rho < 1280) return rho; const int t = (rho - 1280) >> 8, i = (rho - 1280) & 255; return i < 128 ? 1280 + 128 * t + i : 2304 + 128 * t + (i - 128); }

struct Args { const float* in[16]; float* out; unsigned char* ws; };

__global__ void __launch_bounds__(512, 2) mega_fwd(Args args) {
    extern __shared__ __attribute__((aligned(16))) unsigned char lds_raw[];
    LAS unsigned char* lds = (LAS unsigned char*)lds_raw;
    volatile LAS unsigned* MISC = (volatile LAS unsigned*)(lds + MISC_OFF);
    const int tid = threadIdx.x, lane = tid & 63, wave = __builtin_amdgcn_readfirstlane(tid >> 6);
    const int G = gridDim.x, bx = blockIdx.x;
    const int vcu = (G % 8 == 0) ? (bx % 8) * (G / 8) + bx / 8 : bx;
    unsigned char* ws = args.ws;
    unsigned* ctl = (unsigned*)(ws + WS_CTL);
    const float* x = args.in[0]; const float* g_ffn1 = args.in[1]; const float* w_up1 = args.in[2]; const float* w_dn1 = args.in[3]; const float* g_mix = args.in[4]; const float* w_in = args.in[5];
    const float* b_gate = args.in[6]; const float* sink = args.in[7]; const float* rel_bias = args.in[8]; const float* w_a = args.in[9]; const float* w_b = args.in[10]; const float* w_o = args.in[11];
    const float* g_ffn2 = args.in[12]; const float* w_up2 = args.in[13]; const float* w_dn2 = args.in[14]; const float* g_final = args.in[15];
    float* out = args.out;
    bf16_t* Wup1 = (bf16_t*)(ws + WS_WUP1); bf16_t* Wdn1 = (bf16_t*)(ws + WS_WDN1); bf16_t* Win = (bf16_t*)(ws + WS_WIN); bf16_t* Wab = (bf16_t*)(ws + WS_WAB); bf16_t* Wo = (bf16_t*)(ws + WS_WO);
    bf16_t* Wup2 = (bf16_t*)(ws + WS_WUP2); bf16_t* Wdn2 = (bf16_t*)(ws + WS_WDN2); bf16_t* Tm = (bf16_t*)(ws + WS_TM); bf16_t* XB = (bf16_t*)(ws + WS_XB);
    bf16_t* AFF = (bf16_t*)(ws + WS_AFF); bf16_t* QKV = (bf16_t*)(ws + WS_QKV); bf16_t* FT = (bf16_t*)(ws + WS_FT); bf16_t* GATES = (bf16_t*)(ws + WS_GATES); bf16_t* AOPQ = (bf16_t*)(ws + WS_AOPQ);
    float* RS0 = (float*)(ws + WS_RS); float* RS1 = (float*)(ws + WS_RS + RS_BYTES); float* RS2 = (float*)(ws + WS_RS + 2 * RS_BYTES); float* RS3 = (float*)(ws + WS_RS + 3 * RS_BYTES);

    for (int u = tid; u < (LDS_BYTES - LDSCTL_OFF) / 4; u += 512) ((LAS unsigned*)(lds + LDSCTL_OFF))[u] = 0u;
    __syncthreads();
    if (PROBE_K >= 0 && bx == 0 && tid == 0) { const unsigned long long t_ = __builtin_amdgcn_s_memrealtime(); MISC[18] = (unsigned)t_; MISC[19] = (unsigned)(t_ >> 32); }
    XcdBarrier bar = xcd_barrier_post(ctl + 1024, MISC + 8);
    unsigned* grp_cnt = ctl + 8192 + 64 * (bx & 7); unsigned* grp_census = ctl + 6144 + 16 * (bx & 7); unsigned grp_gen = 0u; bool grp_pure = false;
    if (tid == 0) (void)xb_add(grp_census + (bar.x & 15u), 1u);
#define GRID_BAR() xcd_barrier(bar)
#define STAMP(k) do { if ((k) == PROBE_K && bx == 0 && tid == 0) { const unsigned long long t_ = __builtin_amdgcn_s_memrealtime(); MISC[16] = (unsigned)t_; MISC[17] = (unsigned)(t_ >> 32); } } while (0)
#define GROUP_BAR() do { ++grp_gen; group_barrier(grp_cnt, grp_gen * (unsigned)(G / 8), grp_pure, ctl + 1024 + XB_TMO); } while (0)
#ifndef REPEAT
#define REPEAT -1
#endif
#ifndef NREP
#define NREP 2
#endif
#define PH(n) for (int rep_ = 0; rep_ < ((n) == REPEAT ? NREP : 1); ++rep_)

    constexpr int I_UP = 16 * (NUP / 32), I_DN = (DFF / 64) * (DM / 32), I_IN = 16 * (INW / 32), I_A = 8 * 32, I_O = 16 * 32;
    constexpr int NITEMS = 2 * I_UP + 2 * I_DN + I_IN + I_A + I_O;
    LAS float* cosT = (LAS float*)(lds + 8 * 8448);
    auto p0_transposes = [&](const int IT0, const int IT1, const int GW_, const int NGW_) {
        {
            LAS float* scr = (LAS float*)(lds + wave * 8448);
            const int kr = lane >> 3, c4 = lane & 7;
            struct TI { const float* src; const float* gk; bf16_t* dst; int ldsrc, ldd, k0; float cs; };
            auto decode = [&](int it, TI& t) {
                int r = it;
                if (r < 2 * I_UP) { const int second = r >= I_UP; if (second) r -= I_UP; const int nb = r % (NUP / 32), kb = r / (NUP / 32);
                    t.src = (second ? w_up2 : w_up1) + map_up(32 * nb); t.ldsrc = NUP; t.gk = second ? g_ffn2 : g_ffn1; t.cs = 1.0f; t.dst = (second ? Wup2 : Wup1) + (size_t)(32 * nb) * DM; t.ldd = DM; t.k0 = 64 * kb; return; }
                r -= 2 * I_UP;
                if (r < 2 * I_DN) { const int second = r >= I_DN; if (second) r -= I_DN; const int nb = r % 32, kb = r / 32;
                    t.src = (second ? w_dn2 : w_dn1) + 32 * nb; t.ldsrc = DM; t.gk = nullptr; t.cs = 1.0f; t.dst = (second ? Wdn2 : Wdn1) + (size_t)(32 * nb) * DFF; t.ldd = DFF; t.k0 = 64 * kb; return; }
                r -= 2 * I_DN;
                if (r < I_IN) { const int nb = r % (INW / 32), kb = r / (INW / 32);
                    t.src = w_in + map_in(32 * nb); t.ldsrc = INW; t.gk = g_mix; t.cs = (32 * nb < 512) ? QSCALE : 1.0f; t.dst = Win + (size_t)(32 * nb) * DM; t.ldd = DM; t.k0 = 64 * kb; return; }
                r -= I_IN;
                if (r < I_A) { const int nb = r % 32, kb = r / 32; t.src = w_a + 32 * nb; t.ldsrc = DM; t.gk = nullptr; t.cs = 1.0f; t.dst = Wab + (size_t)(32 * nb) * KAB; t.ldd = KAB; t.k0 = 64 * kb; return; }
                r -= I_A;
                { const int nb = r % 32, kb = r / 32; t.src = w_o + 32 * nb; t.ldsrc = DM; t.gk = nullptr; t.cs = 1.0f; t.dst = Wo + (size_t)(32 * nb) * DM; t.ldd = DM; t.k0 = 64 * kb; }
            };
            f32x4 cur[8], nxt[8]; float gc[8], gn[8];
            TI tc, tn;
            int it = IT0 + GW_;
            if (it < IT1) { decode(it, tc);
#pragma unroll
                for (int i = 0; i < 8; ++i) { const int k = tc.k0 + 8 * i + kr; cur[i] = *(const f32x4*)(tc.src + (size_t)k * tc.ldsrc + 4 * c4); gc[i] = tc.gk ? tc.gk[k] : 1.0f; } }
            while (it < IT1) {
                const int itn = it + NGW_; const bool hn = itn < IT1;
                if (hn) { decode(itn, tn);
#pragma unroll
                    for (int i = 0; i < 8; ++i) { const int k = tn.k0 + 8 * i + kr; nxt[i] = *(const f32x4*)(tn.src + (size_t)k * tn.ldsrc + 4 * c4); gn[i] = tn.gk ? tn.gk[k] : 1.0f; } }
#pragma unroll
                for (int i = 0; i < 8; ++i) { const float sc = gc[i] * tc.cs; LAS float* p = scr + (8 * i + kr) * 33 + 4 * c4; p[0] = cur[i][0] * sc; p[1] = cur[i][1] * sc; p[2] = cur[i][2] * sc; p[3] = cur[i][3] * sc; }
                asm volatile("s_waitcnt lgkmcnt(0)" ::: "memory");
                { const int c = lane & 7;
#pragma unroll
                  for (int j = 0; j < 4; ++j) { const int n = (lane >> 3) + 8 * j; const LAS float* s = scr + (8 * c) * 33 + n;
                      u32x4 o; o.x = cvtpk(s[0 * 33], s[1 * 33]); o.y = cvtpk(s[2 * 33], s[3 * 33]); o.z = cvtpk(s[4 * 33], s[5 * 33]); o.w = cvtpk(s[6 * 33], s[7 * 33]);
                      st16(tc.dst + (size_t)n * tc.ldd + tc.k0 + 8 * c, o); } }
                asm volatile("s_waitcnt lgkmcnt(0)" ::: "memory");
                if (hn) { tc = tn;
#pragma unroll
                    for (int i = 0; i < 8; ++i) { cur[i] = nxt[i]; gc[i] = gn[i]; } }
                it = itn;
            }
        }
    };
    auto p0_xb = [&](const int GW_, const int NGW_) {
        {
            f32x4 v[4], w[4]; int m = GW_;
            if (m < MTOK) { const f32x4* xr = (const f32x4*)(x + (size_t)m * DM) + 2 * lane;
#pragma unroll
                for (int j = 0; j < 2; ++j) { v[2 * j] = xr[128 * j]; v[2 * j + 1] = xr[128 * j + 1]; } }
            while (m < MTOK) {
                const int mn = m + NGW_;
                if (mn < MTOK) { const f32x4* xr = (const f32x4*)(x + (size_t)mn * DM) + 2 * lane;
#pragma unroll
                    for (int j = 0; j < 2; ++j) { w[2 * j] = xr[128 * j]; w[2 * j + 1] = xr[128 * j + 1]; } }
                float s = 0.f;
#pragma unroll
                for (int j = 0; j < 4; ++j) s += (v[j][0] * v[j][0] + v[j][1] * v[j][1]) + (v[j][2] * v[j][2] + v[j][3] * v[j][3]);
                s = wave_sum(s);
#pragma unroll
                for (int j = 0; j < 2; ++j) st16(brow(XB, m, DM) + 512 * j + 8 * lane, pack8(v[2 * j], v[2 * j + 1]));
                if (lane == 0) *(f32x4*)(RS0 + (size_t)m * 4) = (f32x4){s, 0.f, 0.f, 0.f};
#pragma unroll
                for (int j = 0; j < 4; ++j) v[j] = w[j];
                m = mn;
            }
        }
    };
    auto p0_fold_tm = [&](const int GW_, const int NGW_) {
        {
            LAS float* tab = (LAS float*)(lds + 8 * 8448 + 8192 + wave * 4096);
            for (int item = GW_; item < 2048; item += NGW_) {
                const int kg = item >> 4, ng = item & 15, g = kg >> 5, j0 = (8 * kg) & 255, part = j0 >> 7, c0 = j0 & 127, n = 64 * ng + lane;
#pragma unroll
                for (int i = 0; i < 16; ++i) { const int idx = lane + 64 * i, cp = idx >> 3, e = idx & 7, ph = ((c0 + e) * cp) & 127; tab[idx] = part ? -cosT[(16 * ph - 512) & 2047] : cosT[16 * ph]; }
                asm volatile("s_waitcnt lgkmcnt(0)" ::: "memory");
                float a8[8];
#pragma unroll
                for (int e = 0; e < 8; ++e) a8[e] = 0.f;
                const float* wp = w_b + (size_t)(g * 128) * DM + n;
                float wa[16], wb[16];
#pragma unroll
                for (int i = 0; i < 16; ++i) wa[i] = wp[(size_t)i * DM];
#pragma unroll 1
                for (int cb = 0; cb < 128; cb += 32) {
#pragma unroll
                    for (int i = 0; i < 16; ++i) wb[i] = wp[(size_t)(cb + 16 + i) * DM];
#pragma unroll
                    for (int i = 0; i < 16; ++i) { const int cp = cb + i; const float w = wa[i]; const f32x4 t0 = *(const LAS f32x4*)(tab + cp * 8), t1 = *(const LAS f32x4*)(tab + cp * 8 + 4);
                        a8[0] += w * t0[0]; a8[1] += w * t0[1]; a8[2] += w * t0[2]; a8[3] += w * t0[3]; a8[4] += w * t1[0]; a8[5] += w * t1[1]; a8[6] += w * t1[2]; a8[7] += w * t1[3];
                        if ((i & 3) == 3) asm volatile("" : "+v"(a8[0]), "+v"(a8[1]), "+v"(a8[2]), "+v"(a8[3]), "+v"(a8[4]), "+v"(a8[5]), "+v"(a8[6]), "+v"(a8[7])); }
                    if (cb + 32 < 128) {
#pragma unroll
                        for (int i = 0; i < 16; ++i) wa[i] = wp[(size_t)(cb + 32 + i) * DM]; }
#pragma unroll
                    for (int i = 0; i < 16; ++i) { const int cp = cb + 16 + i; const float w = wb[i]; const f32x4 t0 = *(const LAS f32x4*)(tab + cp * 8), t1 = *(const LAS f32x4*)(tab + cp * 8 + 4);
                        a8[0] += w * t0[0]; a8[1] += w * t0[1]; a8[2] += w * t0[2]; a8[3] += w * t0[3]; a8[4] += w * t1[0]; a8[5] += w * t1[1]; a8[6] += w * t1[2]; a8[7] += w * t1[3];
                        if ((i & 3) == 3) asm volatile("" : "+v"(a8[0]), "+v"(a8[1]), "+v"(a8[2]), "+v"(a8[3]), "+v"(a8[4]), "+v"(a8[5]), "+v"(a8[6]), "+v"(a8[7])); }
                }
                const float sc = 0.08838834764831845f;
                u32x4 o; o.x = cvtpk(a8[0] * sc, a8[1] * sc); o.y = cvtpk(a8[2] * sc, a8[3] * sc); o.z = cvtpk(a8[4] * sc, a8[5] * sc); o.w = cvtpk(a8[6] * sc, a8[7] * sc);
                st16(Wab + (size_t)n * KAB + 512 + 8 * kg, o);
                asm volatile("s_waitcnt lgkmcnt(0)" ::: "memory");
            }
        }
    };
    auto p0_tm = [&](const int GW_, const int NGW_) {
        for (int idx = GW_ * 64 + lane; idx < 2048 * 256; idx += NGW_ * 64) {
            const int rT = idx >> 8, s0 = (idx & 255) * 8, part = rT >> 10, k = (rT == 1024) ? 1024 : (rT & 1023); const float sc = 0.022097086912079608f;
            float v[8];
#pragma unroll
            for (int e = 0; e < 8; ++e) { const int ph = (k * (s0 + e)) & 2047; v[e] = cosT[(part && rT != 1024) ? ((ph - 512) & 2047) : ph] * sc; }
            u32x4 o; o.x = cvtpk(v[0], v[1]); o.y = cvtpk(v[2], v[3]); o.z = cvtpk(v[4], v[5]); o.w = cvtpk(v[6], v[7]);
            st16(Tm + (size_t)rT * SEQ + s0, o);
        }
    };
    PH(0) {
        const int gw = vcu * 8 + wave, NGW = G * 8;
        for (int j = tid; j < 2048; j += 512) cosT[j] = cospif((float)j * (1.0f / 1024.0f));
        __syncthreads();
        if (wave & 1) p0_fold_tm(gw, NGW);
        p0_xb(gw, NGW);
        p0_transposes(0, I_UP, gw, NGW);
        if (!(wave & 1)) p0_fold_tm(gw, NGW);
        __syncthreads();
    }
    GRID_BAR(); STAMP(1);
    grp_pure = (G % 8 == 0) && (xb_ld(grp_census + (bar.x & 15u)) == (unsigned)(G / 8));

    PH(1) { SchedPlain S; S.T.init(MTOK, NUP, G, bx); S.A = (const char*)XB; S.Bt = (const char*)Wup1; S.tA = (size_t)256 * DM * 2; S.tB = (size_t)256 * DM * 2;
      EpiSwiGLU E{RS0, AFF}; pg8::gemm_phase<EpiSwiGLU, SchedPlain, true>(lds, pg8::GemmP{DM, DM, DM}, S, E); }
    if (2 * bx >= G) {
        const int gw = (bx - G / 2) * 8 + wave, NGW = (G - G / 2) * 8;
        for (int j = tid; j < 2048; j += 512) cosT[j] = cospif((float)j * (1.0f / 1024.0f));
        __syncthreads();
        p0_transposes(I_UP, NITEMS, gw, NGW);
        p0_tm(gw, NGW);
        __syncthreads();
    }
    GRID_BAR(); STAMP(2);
    PH(2) { SchedPlain S; S.T.init(MTOK, DM, G, bx); S.A = (const char*)AFF; S.Bt = (const char*)Wdn1; S.tA = (size_t)256 * DFF * 2; S.tB = (size_t)256 * DFF * 2;
      EpiResid<true> E{x, XB, RS1, 0.5f}; pg8::gemm_phase<EpiResid<true>, SchedPlain, false>(lds, pg8::GemmP{DFF, DFF, DFF}, S, E); }
    GROUP_BAR(); STAMP(3);
    PH(3) { SchedWin S; S.T.init(MTOK, 12 * 256, G, bx); S.X = (const char*)XB; S.W = (const char*)Win; S.tX = (size_t)256 * DM * 2; S.tW = (size_t)256 * DM * 2;
      EpiWin E{RS1, b_gate, QKV, FT, GATES}; pg8::gemm_phase<EpiWin, SchedWin, true>(lds, pg8::GemmP{DM, DM, DM}, S, E); }
    GROUP_BAR(); STAMP(4);
    { const int b = bx & 7, ci = bx >> 3;
      if (ci < 16) {
        PH(41) { SchedOne S; S.u0 = Unit{ci >> 1, ci & 1}; S.A = (const char*)(Tm + (size_t)(ci >> 1) * 256 * SEQ); S.Bt = (const char*)(FT + (size_t)b * SLAB_E + (size_t)(ci & 1) * 256 * SEQ);
          EpiDft E{AOPQ, b}; pg8::gemm_phase<EpiDft, SchedOne, false>(lds, pg8::GemmP{SEQ, SEQ, SEQ}, S, E); }
        if (ci < 8) { SchedOne S; S.u0 = Unit{8 * b + ci, 12}; S.A = (const char*)(brow(XB, (8 * b + ci) * 256, DM)); S.Bt = (const char*)(Win + (size_t)12 * 256 * DM);
          EpiWin E{RS1, b_gate, QKV, FT, GATES}; pg8::gemm_phase<EpiWin, SchedOne, false>(lds, pg8::GemmP{DM, DM, DM}, S, E); }
      } else {
        PH(42) { for (int r = 0; r < 2; ++r) { const int a = 2 * (ci - 16) + r;
            att::attn_unit(lds, (LAS float*)(lds + BIAS_OFF), (LAS float*)(lds + WSF_OFF), QKV, AOPQ, sink, rel_bias, b, a & 1, a >> 1);
            asm volatile("s_waitcnt lgkmcnt(0)" ::: "memory"); __builtin_amdgcn_s_barrier(); } }
      }
    }
    GROUP_BAR(); STAMP(5);
    PH(5) { SchedPlain S; S.T.init(MTOK, DM, G, bx); S.A = (const char*)AOPQ; S.Bt = (const char*)Wab; S.tA = (size_t)256 * KAB * 2; S.tB = (size_t)256 * KAB * 2;
      EpiGate E{GATES}; pg8::gemm_phase<EpiGate, SchedPlain, false>(lds, pg8::GemmP{KAB, KAB, KAB}, S, E); }
    GROUP_BAR(); STAMP(6);
    PH(6) { SchedPlain S; S.T.init(MTOK, DM, G, bx); S.A = (const char*)GATES; S.Bt = (const char*)Wo; S.tA = (size_t)256 * 2048 * 2; S.tB = (size_t)256 * DM * 2;
      EpiResid<false> E{nullptr, XB, RS2, 1.0f}; pg8::gemm_phase<EpiResid<false>, SchedPlain, false>(lds, pg8::GemmP{DM, 2048, DM}, S, E); }
    GROUP_BAR(); STAMP(7);
    PH(7) { SchedPlain S; S.T.init(MTOK, NUP, G, bx); S.A = (const char*)XB; S.Bt = (const char*)Wup2; S.tA = (size_t)256 * DM * 2; S.tB = (size_t)256 * DM * 2;
      EpiSwiGLU E{RS2, AFF}; pg8::gemm_phase<EpiSwiGLU, SchedPlain, true>(lds, pg8::GemmP{DM, DM, DM}, S, E); }
    GROUP_BAR(); STAMP(8);
    PH(8) { SchedPlain S; S.T.init(MTOK, DM, G, bx); S.A = (const char*)AFF; S.Bt = (const char*)Wdn2; S.tA = (size_t)256 * DFF * 2; S.tB = (size_t)256 * DFF * 2;
      ++grp_gen; EpiFinal E{XB, out, RS3, g_final, 0.5f, grp_cnt, grp_gen * (unsigned)(G / 8), grp_pure, ctl + 1024 + XB_TMO};
      pg8::gemm_phase<EpiFinal, SchedPlain, false>(lds, pg8::GemmP{DFF, DFF, DFF}, S, E); }
    if (PROBE_K >= 0 && bx == 0 && tid == 0) { const unsigned long long t_sel = ((unsigned long long)MISC[17] << 32) | MISC[16], t_start = ((unsigned long long)MISC[19] << 32) | MISC[18]; const unsigned long long t_end = __builtin_amdgcn_s_memrealtime(), want = 4ull * (t_sel - t_start); while (__builtin_amdgcn_s_memrealtime() - t_end < want) __builtin_amdgcn_s_sleep(8); }
}

extern "C" void kernel_launch(void* const* d_in, const int* in_sizes, int n_in, void* d_out, int out_size, void* d_ws, size_t ws_size, hipStream_t stream) {
    static int grid = 0;
    if (grid == 0) {
        if (n_in != 16 || in_sizes[0] != MTOK * DM || out_size != MTOK * DM || ws_size < WS_END) { fprintf(stderr, "kernel_launch: unexpected shapes (n_in %d, ws %zu)\n", n_in, ws_size); grid = -1; return; }
        int dev = 0, cus = 0, per_cu = 0;
        if (hipGetDevice(&dev) != hipSuccess || hipDeviceGetAttribute(&cus, hipDeviceAttributeMultiprocessorCount, dev) != hipSuccess) { grid = -1; return; }
        if (hipFuncSetAttribute((const void*)mega_fwd, hipFuncAttributeMaxDynamicSharedMemorySize, LDS_BYTES) != hipSuccess) { fprintf(stderr, "kernel_launch: hipFuncSetAttribute failed\n"); grid = -1; return; }
        if (hipOccupancyMaxActiveBlocksPerMultiprocessor(&per_cu, (const void*)mega_fwd, 512, LDS_BYTES) != hipSuccess || per_cu < 1) { fprintf(stderr, "kernel_launch: occupancy query says %d\n", per_cu); }
        (void)hipGetLastError();
        grid = cus;
        if (grid != 256) { fprintf(stderr, "kernel_launch: needs 256 CUs, device has %d\n", cus); grid = -1; return; }
    }
    if (grid < 0) return;
    if (hipMemsetAsync((char*)d_ws + WS_CTL, 0, CTL_ZERO_BYTES, stream) != hipSuccess) return;
    Args a{};
    for (int i = 0; i < 16; ++i) a.in[i] = (const float*)d_in[i];
    a.out = (float*)d_out; a.ws = (unsigned char*)d_ws;
    hipLaunchKernelGGL(mega_fwd, dim3(grid), dim3(512), LDS_BYTES, stream, a);
}
```

```cpp
#include <hip/hip_runtime.h>
#include <cstdio>
#include <cstdint>
#include <cmath>

#ifndef PROBE_K
#define PROBE_K -1
#endif
#define LAS __attribute__((address_space(3)))
#define GAS __attribute__((address_space(1)))
typedef unsigned short bf16_t;
typedef short bf16x8 __attribute__((ext_vector_type(8)));
typedef float f32x4 __attribute__((ext_vector_type(4)));
typedef float f32x16 __attribute__((ext_vector_type(16)));
typedef unsigned u32x4 __attribute__((ext_vector_type(4)));
typedef float f32x2_t __attribute__((ext_vector_type(2)));
typedef __bf16 bf16x2_t __attribute__((ext_vector_type(2)));
typedef short s16x4 __attribute__((ext_vector_type(4)));

constexpr int DM = 1024, NB = 8, SEQ = 2048, MTOK = NB * SEQ, DFF = 2816, NUP = 2 * DFF, INW = 3328;
constexpr int KAB = 1536;
constexpr float LOG2E = 1.4426950408889634f;
constexpr float QSCALE = 0.125f * LOG2E;
constexpr float RMS_EPS = 1e-6f;
constexpr size_t SLAB = (size_t)23 << 20, SLAB_E = SLAB / 2;
__device__ __forceinline__ unsigned short* brow(unsigned short* base, int row, int pitch) { return base + (size_t)(row >> 11) * SLAB_E + (size_t)(row & 2047) * pitch; }
__device__ __forceinline__ const unsigned short* brow(const unsigned short* base, int row, int pitch) { return base + (size_t)(row >> 11) * SLAB_E + (size_t)(row & 2047) * pitch; }

__device__ __forceinline__ unsigned cvtpk(float lo, float hi) { f32x2_t v = {lo, hi}; bf16x2_t b = __builtin_convertvector(v, bf16x2_t); return __builtin_bit_cast(unsigned, b); }
__device__ __forceinline__ u32x4 pack8(f32x4 a, f32x4 b) { u32x4 w; w.x = cvtpk(a[0], a[1]); w.y = cvtpk(a[2], a[3]); w.z = cvtpk(b[0], b[1]); w.w = cvtpk(b[2], b[3]); return w; }
#ifndef WT_STORES
#define WT_STORES 0
#endif
__device__ __forceinline__ void st16(void* p, u32x4 v) {
#if WT_STORES
    asm volatile("global_store_dwordx4 %0, %1, off sc1\n\ts_nop 1" :: "v"(p), "v"(v) : "memory");
#else
    *(u32x4*)p = v;
#endif
}
__device__ __forceinline__ void st16f(void* p, f32x4 v) { st16(p, __builtin_bit_cast(u32x4, v)); }
__device__ __forceinline__ void unpack8(u32x4 w, f32x4& a, f32x4& b) {
    a[0] = __builtin_bit_cast(float, w.x << 16); a[1] = __builtin_bit_cast(float, w.x & 0xffff0000u); a[2] = __builtin_bit_cast(float, w.y << 16); a[3] = __builtin_bit_cast(float, w.y & 0xffff0000u);
    b[0] = __builtin_bit_cast(float, w.z << 16); b[1] = __builtin_bit_cast(float, w.z & 0xffff0000u); b[2] = __builtin_bit_cast(float, w.w << 16); b[3] = __builtin_bit_cast(float, w.w & 0xffff0000u);
}
__device__ __forceinline__ float bf2f(unsigned short h) { return __builtin_bit_cast(float, (unsigned)h << 16); }
__device__ __forceinline__ float row_rinv(const float* RS, int row) { const f32x4 p = *(const f32x4*)(RS + 4 * (size_t)row); return rsqrtf(((p[0] + p[1]) + (p[2] + p[3])) * (1.0f / DM) + RMS_EPS); }

namespace pg8 {
constexpr int BM = 256, BK = 64, HALF = 128, HTB = HALF * BK * 2, STAGE_BYTES = 8 * HTB, NXCD = 8, WGM = 8;
__host__ __device__ __forceinline__ int lds_byte(int r, int c) { return (r >> 3) * 1024 + (r & 7) * 128 + (((c >> 3) ^ ((r >> 1) & 7)) * 16) + (c & 7) * 2; }
__host__ __device__ __forceinline__ void stage_rc(int b, int& R, int& C) { const int st = b / 1024, ob = b % 1024; R = st * 8 + (ob >> 7); C = ((((ob >> 4) & 7) ^ ((R >> 1) & 7)) * 8); }
__host__ __device__ __forceinline__ int perm32(int rho) { const int n = rho >> 4, i = rho & 15; return 8 * (i >> 2) + 4 * n + (i & 3); }

struct Unit { int pm, pn; };
struct GemmP { int K, lda, ldb; };

struct TileOrder {
    int nM, nN, nwg, G, c;
    __device__ void init(int M, int N, int G_, int c_) { nM = M / BM; nN = N / BM; nwg = nM * nN; G = G_; c = c_; }
    __device__ bool tile(int i, Unit& u) const {
        const long L = (long)i * G + c; if (L >= nwg) return false;
        int wgid = (int)L; { const int q = nwg / NXCD, r = nwg % NXCD, xcd = wgid % NXCD, off = wgid / NXCD; wgid = (xcd < r ? xcd * (q + 1) : r * (q + 1) + (xcd - r) * q) + off; }
        const int nig = WGM * nN, gid = wgid / nig, fm = gid * WGM, gsz = (nM - fm) < WGM ? (nM - fm) : WGM;
        u.pm = fm + ((wgid % nig) % gsz); u.pn = (wgid % nig) / gsz; return true;
    }
};

template <class Epi, class Sched, bool ALIGN_EPI>
__device__ __forceinline__ void gemm_phase(LAS unsigned char* lds, const GemmP g, const Sched& S, const Epi& E) {
    int tid = threadIdx.x; asm volatile("" : "+v"(tid));
    const int wid = __builtin_amdgcn_readfirstlane(tid >> 6), lane = tid & 63, wr = wid >> 2, wc = wid & 3, fr = lane & 15, fq = lane >> 4;
    const int K = g.K, nt = K / BK;
    unsigned voffA[2], voffB[2];
#pragma unroll
    for (int i = 0; i < 2; ++i) { int R, C; stage_rc(tid * 16 + i * 8192, R, C); const int Rb = (R & ~31) + perm32(R & 31);
        voffA[i] = (unsigned)(R * g.lda + C) * 2u; voffB[i] = (unsigned)(Rb * g.ldb + C) * 2u; }
    const size_t kstep = (size_t)(BK * 2);
    const size_t hstepA = (size_t)HALF * g.lda * 2, hstepB = (size_t)HALF * g.ldb * 2;
    const unsigned ldsw = (unsigned)wid * 1024u;
    const int aoffk[2] = {lds_byte(wr * 64 + fr, fq * 8), lds_byte(wr * 64 + fr, 32 + fq * 8)}, boffk[2] = {lds_byte(wc * 32 + fr, fq * 8), lds_byte(wc * 32 + fr, 32 + fq * 8)};
#define PG8_SA(b, h) (((b) * 2 + (h)) * HTB)
#define PG8_SB(b, h) ((4 + (b) * 2 + (h)) * HTB)
#define PG8_STAGE(bufoff, gbase, voff) do { _Pragma("unroll") for (int _i = 0; _i < 2; ++_i) \
        __builtin_amdgcn_global_load_lds((const unsigned*)((const char*)(gbase) + (voff)[_i]), (LAS unsigned*)(lds + (bufoff) + ldsw + _i * 8192), 16, 0, 0); } while (0)
#define PG8_LDA(dst, b, h) do { _Pragma("unroll") for (int m = 0; m < 4; ++m) _Pragma("unroll") for (int k = 0; k < 2; ++k) dst[m][k] = *(const LAS bf16x8*)(lds + PG8_SA(b, h) + aoffk[k] + m * 2048); } while (0)
#define PG8_LDB(dst, b, h) do { _Pragma("unroll") for (int n = 0; n < 2; ++n) _Pragma("unroll") for (int k = 0; k < 2; ++k) dst[n][k] = *(const LAS bf16x8*)(lds + PG8_SB(b, h) + boffk[k] + n * 2048); } while (0)
#define PG8_MMA(ai, bj, At, Bt) do { __builtin_amdgcn_s_setprio(1); _Pragma("unroll") for (int m = 0; m < 4; ++m) _Pragma("unroll") for (int n = 0; n < 2; ++n) _Pragma("unroll") for (int k = 0; k < 2; ++k) \
        acc[ai][bj][m][n] = __builtin_amdgcn_mfma_f32_16x16x32_bf16(Bt[n][k], At[m][k], acc[ai][bj][m][n], 0, 0, 0); __builtin_amdgcn_s_setprio(0); } while (0)
#define PG8_WAIT_V(n) asm volatile("s_waitcnt vmcnt(" #n ")" ::: "memory")
#define PG8_WAIT_L(n) asm volatile("s_waitcnt lgkmcnt(" #n ")" ::: "memory")
#define PG8_BAR __builtin_amdgcn_s_barrier()
#define PG8_SCHED __builtin_amdgcn_sched_barrier(0)
    Unit cur, nxt; int ui = 0;
    if (!S.next(0, cur)) return;
    f32x4 acc[2][2][4][2];
#pragma unroll
    for (int a = 0; a < 2; ++a)
#pragma unroll
        for (int b = 0; b < 2; ++b)
#pragma unroll
            for (int m = 0; m < 4; ++m)
#pragma unroll
                for (int n = 0; n < 2; ++n) acc[a][b][m][n] = (f32x4){0.f, 0.f, 0.f, 0.f};
    bf16x8 At[4][2], B0[2][2], B1[2][2];
    const char* cA = S.opA(cur); const char* cB = S.opB(cur);
    PG8_STAGE(PG8_SB(0, 0), cB, voffB); PG8_STAGE(PG8_SB(0, 1), cB + hstepB, voffB); PG8_STAGE(PG8_SA(0, 0), cA, voffA); PG8_STAGE(PG8_SA(0, 1), cA + hstepA, voffA);
    if (wr == 1) PG8_BAR;
    PG8_WAIT_V(2); PG8_BAR;
    PG8_STAGE(PG8_SB(1, 0), cB + kstep, voffB); PG8_STAGE(PG8_SA(1, 0), cA + kstep, voffA); PG8_STAGE(PG8_SB(1, 1), cB + hstepB + kstep, voffB);
    PG8_WAIT_V(6); PG8_BAR;
    for (;;) {
        const bool has_next = S.next(ui + 1, nxt);
        const char* nA = has_next ? S.opA(nxt) : cA; const char* nB = has_next ? S.opB(nxt) : cB;
        for (int t = 0; t < nt; t += 2) {
            const bool last = (t == nt - 2);
            const char* a1 = cA + (size_t)(t + 1) * kstep;
            const char* a2 = last ? nA : cA + (size_t)(t + 2) * kstep; const char* b2 = last ? nB : cB + (size_t)(t + 2) * kstep;
            const char* a3 = a2 + kstep; const char* b3 = b2 + kstep;
            if constexpr (Epi::MID_T >= 0) { if (t == Epi::MID_T) E.mid(acc, cur, wr, wc, fr, fq); }
            PG8_LDB(B0, 0, 0); PG8_LDB(B1, 0, 1); PG8_SCHED; PG8_LDA(At, 0, 0); PG8_STAGE(PG8_SA(1, 1), a1 + hstepA, voffA);
            PG8_WAIT_V(8); PG8_WAIT_L(0); PG8_BAR; PG8_MMA(0, 0, At, B0); PG8_MMA(0, 1, At, B1); PG8_BAR; PG8_SCHED;
            PG8_LDA(At, 0, 1); PG8_STAGE(PG8_SB(0, 0), b2, voffB); PG8_STAGE(PG8_SB(0, 1), b2 + hstepB, voffB); PG8_STAGE(PG8_SA(0, 0), a2, voffA);
            PG8_WAIT_V(8); PG8_WAIT_L(0); PG8_BAR; PG8_MMA(1, 0, At, B0); PG8_MMA(1, 1, At, B1); PG8_BAR; PG8_SCHED;
            PG8_LDB(B0, 1, 0); PG8_LDB(B1, 1, 1); PG8_SCHED; PG8_LDA(At, 1, 0); PG8_STAGE(PG8_SA(0, 1), a2 + hstepA, voffA);
            PG8_WAIT_V(8); PG8_WAIT_L(0); PG8_BAR; PG8_MMA(0, 0, At, B0); PG8_MMA(0, 1, At, B1); PG8_BAR; PG8_SCHED;
            PG8_LDA(At, 1, 1); PG8_STAGE(PG8_SB(1, 0), b3, voffB); PG8_STAGE(PG8_SB(1, 1), b3 + hstepB, voffB); PG8_STAGE(PG8_SA(1, 0), a3, voffA);
            PG8_WAIT_V(8); PG8_WAIT_L(0); PG8_BAR; PG8_MMA(1, 0, At, B0); PG8_MMA(1, 1, At, B1); PG8_BAR; PG8_SCHED;
        }
        if constexpr (ALIGN_EPI) { if (wr == 0) PG8_BAR; }
        if constexpr (!Epi::AFTER_DRAIN) { E(acc, cur, wr, wc, fr, fq); }
        if (!has_next) break;
#pragma unroll
        for (int a = 0; a < 2; ++a)
#pragma unroll
            for (int b = 0; b < 2; ++b)
#pragma unroll
                for (int m = 0; m < 4; ++m)
#pragma unroll
                    for (int n = 0; n < 2; ++n) acc[a][b][m][n] = (f32x4){0.f, 0.f, 0.f, 0.f};
        cur = nxt; cA = nA; cB = nB; ++ui;
        if constexpr (ALIGN_EPI) { if (wr == 1) PG8_BAR; }
    }
    PG8_WAIT_V(0);
    if constexpr (!ALIGN_EPI) { if (wr == 0) PG8_BAR; }
    PG8_BAR;
    if constexpr (Epi::AFTER_DRAIN) { E.fused(acc, cur, wr, wc, fr, fq, lds, wid, lane); }
#undef PG8_SA
#undef PG8_SB
#undef PG8_STAGE
#undef PG8_LDA
#undef PG8_LDB
#undef PG8_MMA
#undef PG8_WAIT_V
#undef PG8_WAIT_L
#undef PG8_BAR
#undef PG8_SCHED
}
}
using pg8::Unit;
typedef f32x4 Acc[2][2][4][2];

struct SchedPlain {
    pg8::TileOrder T; const char* A; const char* Bt; size_t tA, tB;
    __device__ __forceinline__ bool next(int i, Unit& u) const { return T.tile(i, u); }
    __device__ __forceinline__ const char* opA(const Unit& u) const { return A + (size_t)(u.pm >> 3) * SLAB + (size_t)(u.pm & 7) * tA; }
    __device__ __forceinline__ const char* opB(const Unit& u) const { return Bt + (size_t)u.pn * tB; }
};
struct SchedWin {
    pg8::TileOrder T; const char* X; const char* W; size_t tX, tW;
    __device__ __forceinline__ bool next(int i, Unit& u) const { return T.tile(i, u); }
    __device__ __forceinline__ const char* xp(const Unit& u) const { return X + (size_t)(u.pm >> 3) * SLAB + (size_t)(u.pm & 7) * tX; }
    __device__ __forceinline__ const char* opA(const Unit& u) const { return (u.pn == 3 || u.pn == 4) ? W + (size_t)u.pn * tW : xp(u); }
    __device__ __forceinline__ const char* opB(const Unit& u) const { return (u.pn == 3 || u.pn == 4) ? xp(u) : W + (size_t)u.pn * tW; }
};
struct SchedOne {
    const char* A; const char* Bt; Unit u0;
    __device__ __forceinline__ bool next(int i, Unit& u) const { if (i > 0) return false; u = u0; return true; }
    __device__ __forceinline__ const char* opA(const Unit&) const { return A; }
    __device__ __forceinline__ const char* opB(const Unit&) const { return Bt; }
};

struct SchedDft {
    const char* A; const char* FTb; int pmT;
    __device__ __forceinline__ bool next(int i, Unit& u) const { if (i > 1) return false; u.pm = pmT; u.pn = i; return true; }
    __device__ __forceinline__ const char* opA(const Unit&) const { return A; }
    __device__ __forceinline__ const char* opB(const Unit& u) const { return FTb + (size_t)u.pn * 256 * SEQ * 2; }
};

struct EpiSwiGLU {
    static constexpr bool AFTER_DRAIN = false; static constexpr int MID_T = -1;
    const float* RS; bf16_t* O;
    __device__ __forceinline__ void mid(Acc&, const Unit&, int, int, int, int) const {}
    __device__ __forceinline__ void operator()(const Acc& acc, const Unit& u, int wr, int wc, int fr, int fq) const {
        asm volatile("" : "+v"(fr), "+v"(fq));
        const int row0 = u.pm * 256 + wr * 64 + fr, col0 = u.pn * 128 + wc * 32 + 8 * fq;
        float rv[2][4];
#pragma unroll
        for (int ai = 0; ai < 2; ++ai)
#pragma unroll
            for (int m = 0; m < 4; ++m) rv[ai][m] = row_rinv(RS, row0 + ai * 128 + m * 16);
#pragma unroll
        for (int ai = 0; ai < 2; ++ai)
#pragma unroll
            for (int m = 0; m < 4; ++m) {
                const int row = row0 + ai * 128 + m * 16; const float r = rv[ai][m];
                f32x4 o[2];
#pragma unroll
                for (int n = 0; n < 2; ++n) { const f32x4 g = acc[ai][0][m][n] * r, up = acc[ai][1][m][n] * r;
#pragma unroll
                    for (int j = 0; j < 4; ++j) { const float e = __builtin_amdgcn_exp2f(-g[j] * LOG2E); o[n][j] = g[j] * up[j] * __builtin_amdgcn_rcpf(1.0f + e); } }
                st16(brow(O, row, DFF) + col0, pack8(o[0], o[1]));
            }
    }
};
template <bool XIN_F32> struct EpiResid {
    static constexpr bool AFTER_DRAIN = true; static constexpr int MID_T = -1;
    const float* xin; bf16_t* XB; float* RSo; float alpha;
    __device__ __forceinline__ void mid(Acc&, const Unit&, int, int, int, int) const {}
    __device__ __forceinline__ void operator()(const Acc&, const Unit&, int, int, int, int) const {}
    __device__ __forceinline__ void fused(Acc& acc, const Unit& u, int wr, int wc, int fr, int fq, LAS unsigned char* lds, int wid, int lane) const {
        asm volatile("" : "+v"(fr), "+v"(fq));
        LAS float* P = (LAS float*)lds;
#pragma unroll
        for (int ai = 0; ai < 2; ++ai) {
            u32x4 xr[4][2]; f32x4 xf[2][2][2];
            if constexpr (!XIN_F32) {
#pragma unroll
                for (int m = 0; m < 4; ++m)
#pragma unroll
                    for (int bj = 0; bj < 2; ++bj) xr[m][bj] = *(const u32x4*)(brow(XB, u.pm * 256 + ai * 128 + wr * 64 + m * 16 + fr, DM) + u.pn * 256 + bj * 128 + wc * 32 + 8 * fq);
            }
#pragma unroll
            for (int m = 0; m < 4; ++m) {
                const int rl = ai * 128 + wr * 64 + m * 16 + fr, row = u.pm * 256 + rl; float ss = 0.f;
                if constexpr (XIN_F32) { if ((m & 1) == 0) {
#pragma unroll
                    for (int mm = 0; mm < 2; ++mm)
#pragma unroll
                        for (int bj = 0; bj < 2; ++bj) { const size_t off = (size_t)(row + 16 * mm) * DM + u.pn * 256 + bj * 128 + wc * 32 + 8 * fq; xf[mm][bj][0] = *(const f32x4*)(xin + off); xf[mm][bj][1] = *(const f32x4*)(xin + off + 4); } } }
#pragma unroll
                for (int bj = 0; bj < 2; ++bj) {
                    const int col = u.pn * 256 + bj * 128 + wc * 32 + 8 * fq;
                    bf16_t* xb = brow(XB, row, DM) + col;
                    f32x4 x0, x1;
                    if constexpr (XIN_F32) { x0 = xf[m & 1][bj][0]; x1 = xf[m & 1][bj][1]; }
                    else unpack8(xr[m][bj], x0, x1);
                    x0 = x0 + acc[ai][bj][m][0] * alpha; x1 = x1 + acc[ai][bj][m][1] * alpha;
                    ss += (x0[0] * x0[0] + x0[1] * x0[1]) + (x0[2] * x0[2] + x0[3] * x0[3]) + (x1[0] * x1[0] + x1[1] * x1[1]) + (x1[2] * x1[2] + x1[3] * x1[3]);
                    st16(xb, pack8(x0, x1));
                }
                ss += __shfl_xor(ss, 16); ss += __shfl_xor(ss, 32);
                if (fq == 0) P[rl * 4 + wc] = ss;
            }
        }
        asm volatile("s_waitcnt lgkmcnt(0)" ::: "memory"); __builtin_amdgcn_s_barrier(); asm volatile("" ::: "memory");
        const int tid = wid * 64 + lane;
        if (tid < 256) { const f32x4 p = *(const LAS f32x4*)(P + tid * 4); RSo[(size_t)(u.pm * 256 + tid) * 4 + u.pn] = (p[0] + p[1]) + (p[2] + p[3]); }
    }
};
struct EpiWin {
    static constexpr bool AFTER_DRAIN = false; static constexpr int MID_T = -1;
    const float* RS; const float* bg; bf16_t* QKV; bf16_t* FT; bf16_t* GATES;
    __device__ __forceinline__ void mid(Acc&, const Unit&, int, int, int, int) const {}
    __device__ __forceinline__ void operator()(const Acc& acc, const Unit& u, int wr, int wc, int fr, int fq) const {
        asm volatile("" : "+v"(fr), "+v"(fq));
        if (u.pn < 3) {
            const int row0 = u.pm * 256 + wr * 64 + fr, col0 = u.pn * 256 + wc * 32 + 8 * fq;
            float rv[2][4];
#pragma unroll
            for (int ai = 0; ai < 2; ++ai)
#pragma unroll
                for (int m = 0; m < 4; ++m) rv[ai][m] = row_rinv(RS, row0 + ai * 128 + m * 16);
#pragma unroll
            for (int ai = 0; ai < 2; ++ai)
#pragma unroll
                for (int m = 0; m < 4; ++m) { const int row = row0 + ai * 128 + m * 16; const float r = rv[ai][m];
#pragma unroll
                    for (int bj = 0; bj < 2; ++bj) st16(brow(QKV, row, 768) + col0 + bj * 128, pack8(acc[ai][bj][m][0] * r, acc[ai][bj][m][1] * r)); }
        } else if (u.pn < 5) {
            f32x4 rt[2][2];
#pragma unroll
            for (int bj = 0; bj < 2; ++bj)
#pragma unroll
                for (int n = 0; n < 2; ++n)
#pragma unroll
                    for (int j = 0; j < 4; ++j) rt[bj][n][j] = row_rinv(RS, u.pm * 256 + bj * 128 + wc * 32 + 8 * fq + 4 * n + j);
            const int b = u.pm >> 3, s0 = (u.pm & 7) * 256 + wc * 32 + 8 * fq;
#pragma unroll
            for (int ai = 0; ai < 2; ++ai)
#pragma unroll
                for (int m = 0; m < 4; ++m) { const int ch = (u.pn - 3) * 256 + ai * 128 + wr * 64 + m * 16 + fr; bf16_t* base = FT + (size_t)b * SLAB_E + (size_t)ch * SEQ + s0;
#pragma unroll
                    for (int bj = 0; bj < 2; ++bj) st16(base + bj * 128, pack8(acc[ai][bj][m][0] * rt[bj][0], acc[ai][bj][m][1] * rt[bj][1])); }
        } else {
            const int c0 = (u.pn - 5) * 128 + wc * 32 + 8 * fq, row0 = u.pm * 256 + wr * 64 + fr;
            f32x4 ba[2], bb[2];
#pragma unroll
            for (int n = 0; n < 2; ++n) { ba[n] = *(const f32x4*)(bg + c0 + 4 * n); bb[n] = *(const f32x4*)(bg + DM + c0 + 4 * n); }
            float rv[2][4];
#pragma unroll
            for (int ai = 0; ai < 2; ++ai)
#pragma unroll
                for (int m = 0; m < 4; ++m) rv[ai][m] = row_rinv(RS, row0 + ai * 128 + m * 16);
#pragma unroll
            for (int ai = 0; ai < 2; ++ai)
#pragma unroll
                for (int m = 0; m < 4; ++m) { const int row = row0 + ai * 128 + m * 16; const float r = rv[ai][m];
                    f32x4 ra[2], gb[2];
#pragma unroll
                    for (int n = 0; n < 2; ++n) { const f32x4 za = acc[ai][0][m][n] * r + ba[n], zb = acc[ai][1][m][n] * r + bb[n];
#pragma unroll
                        for (int j = 0; j < 4; ++j) { const float ea = __builtin_amdgcn_exp2f(-za[j] * LOG2E), eb = __builtin_amdgcn_exp2f(-zb[j] * LOG2E);
                            ra[n][j] = (1.0f + eb) * __builtin_amdgcn_rcpf(1.0f + ea); gb[n][j] = __builtin_amdgcn_rcpf(1.0f + eb); } }
                    bf16_t* gp = brow(GATES, row, 2048) + c0; st16(gp, pack8(ra[0], ra[1])); st16(gp + DM, pack8(gb[0], gb[1])); }
        }
    }
};
struct EpiDft {
    static constexpr bool AFTER_DRAIN = false; static constexpr int MID_T = -1;
    bf16_t* AOPQ; int b;
    __device__ __forceinline__ void mid(Acc&, const Unit&, int, int, int, int) const {}
    __device__ __forceinline__ void operator()(const Acc& acc, const Unit& u, int wr, int wc, int fr, int fq) const {
        asm volatile("" : "+v"(fr), "+v"(fq));
        const int part = u.pm >> 2, k0 = (u.pm & 3) * 256 + wr * 64 + fr;
        bf16_t* ab = AOPQ + (size_t)b * SLAB_E + 512 + wc * 32 + 8 * fq;
#pragma unroll
        for (int ai = 0; ai < 2; ++ai)
#pragma unroll
            for (int m = 0; m < 4; ++m) { const int k = k0 + ai * 128 + m * 16;
#pragma unroll
                for (int bj = 0; bj < 2; ++bj) { const int cg = (u.pn * 2 + bj) * 256; const f32x4 v0 = acc[ai][bj][m][0], v1 = acc[ai][bj][m][1];
                    if (part == 0) { const u32x4 w = pack8(v0, v1); st16(ab + (size_t)k * KAB + cg, w); if (k != 0) st16(ab + (size_t)(SEQ - k) * KAB + cg, w); }
                    else if (k != 0) { st16(ab + (size_t)k * KAB + cg + 128, pack8(v0, v1)); st16(ab + (size_t)(SEQ - k) * KAB + cg + 128, pack8(-v0, -v1)); }
                    else { const u32x4 z = (u32x4){0u, 0u, 0u, 0u}; st16(ab + (size_t)1024 * KAB + cg, pack8(v0, v1)); st16(ab + cg + 128, z); st16(ab + (size_t)1024 * KAB + cg + 128, z); } } }
    }
};
struct EpiGate {
    static constexpr bool AFTER_DRAIN = false; static constexpr int MID_T = 8;
    bf16_t* GATES;
    __device__ __forceinline__ void scale(Acc& acc, const Unit& u, int wr, int wc, int fr, int fq, int goff) const {
        asm volatile("" : "+v"(fr), "+v"(fq));
        u32x4 w[2][4][2];
#pragma unroll
        for (int ai = 0; ai < 2; ++ai)
#pragma unroll
            for (int m = 0; m < 4; ++m)
#pragma unroll
                for (int bj = 0; bj < 2; ++bj) w[ai][m][bj] = *(const u32x4*)(brow(GATES, u.pm * 256 + ai * 128 + wr * 64 + m * 16 + fr, 2048) + goff + u.pn * 256 + bj * 128 + wc * 32 + 8 * fq);
#pragma unroll
        for (int ai = 0; ai < 2; ++ai)
#pragma unroll
            for (int m = 0; m < 4; ++m)
#pragma unroll
                for (int bj = 0; bj < 2; ++bj) { f32x4 s0, s1; unpack8(w[ai][m][bj], s0, s1);
                    acc[ai][bj][m][0] = acc[ai][bj][m][0] * s0; acc[ai][bj][m][1] = acc[ai][bj][m][1] * s1; }
    }
    __device__ __forceinline__ void mid(Acc& acc, const Unit& u, int wr, int wc, int fr, int fq) const { scale(acc, u, wr, wc, fr, fq, 0); }
    __device__ __forceinline__ void operator()(Acc& acc, const Unit& u, int wr, int wc, int fr, int fq) const {
        scale(acc, u, wr, wc, fr, fq, DM);
#pragma unroll
        for (int ai = 0; ai < 2; ++ai)
#pragma unroll
            for (int m = 0; m < 4; ++m) { const int row = u.pm * 256 + ai * 128 + wr * 64 + m * 16 + fr;
#pragma unroll
                for (int bj = 0; bj < 2; ++bj) st16(brow(GATES, row, 2048) + u.pn * 256 + bj * 128 + wc * 32 + 8 * fq, pack8(acc[ai][bj][m][0], acc[ai][bj][m][1])); }
    }
};

namespace att {
constexpr int LDS_K = 0, LDS_V = 49152, LDS_OST = 98304;
__device__ __forceinline__ int crow(int r, int hi) { return (r & 3) + 8 * (r >> 2) + 4 * hi; }
__device__ __forceinline__ int t5_bucket(int rel) {
    const int n = rel < 0 ? -rel : rel; int b;
    if (n < 8) b = n; else if (n < 12) b = 8; else if (n < 16) b = 9; else if (n < 23) b = 10; else if (n < 32) b = 11; else if (n < 46) b = 12; else if (n < 64) b = 13; else if (n < 91) b = 14; else b = 15;
    return b + (rel > 0 ? 16 : 0);
}
__device__ __forceinline__ s16x4 vtr(const LAS unsigned char* p) { typedef short v4i16_t __attribute__((ext_vector_type(4))); return __builtin_bit_cast(s16x4, __builtin_amdgcn_ds_read_tr16_b64_v4i16((LAS v4i16_t*)p)); }
__device__ __forceinline__ unsigned short f2bf(float f) { unsigned u = __builtin_bit_cast(unsigned, f); return (unsigned short)((u + 0x7fffu + ((u >> 16) & 1u)) >> 16); }

__device__ __forceinline__ void attn_unit(LAS unsigned char* ring, LAS float* biasT  , LAS float* wsfAll  , const bf16_t* QKV, bf16_t* AOPQ,
                                          const float* sink, const float* relb, int b, int kvh, int n) {
    const int tid = threadIdx.x, lane = tid & 63, r32 = lane & 31, hi = lane >> 5, wid = __builtin_amdgcn_readfirstlane(tid >> 6);
    for (int t = tid; t < 4 * 512; t += 512) { const int g = t >> 9, rel = (t & 511) - 256; biasT[t] = (rel >= -128 && rel <= 128) ? relb[t5_bucket(rel) * 8 + kvh * 4 + g] * LOG2E : -INFINITY; }
    const int tlo = (n == 0) ? 2 : 0, thi = (n == 15) ? 3 : 5;
    const size_t rowb = 0; QKV += (size_t)b * SLAB_E; AOPQ += (size_t)b * SLAB_E; const int key0 = 128 * (n - 1);
    for (int t = tlo; t <= thi; ++t) {
        const bf16_t* ks = QKV + (rowb + key0 + 64 * t + lane) * 768 + 512 + kvh * 64 + wid * 8;
        __builtin_amdgcn_global_load_lds((const unsigned*)ks, (LAS unsigned*)(ring + LDS_K + t * 8192 + wid * 1024), 16, 0, 0);
        const bf16_t* vs = QKV + (rowb + key0 + 64 * t + 16 * (wid & 3) + (lane >> 2)) * 768 + 640 + kvh * 64 + (wid >> 2) * 32 + (lane & 3) * 8;
        __builtin_amdgcn_global_load_lds((const unsigned*)vs, (LAS unsigned*)(ring + LDS_V + t * 8192 + wid * 1024), 16, 0, 0);
    }
    asm volatile("s_waitcnt vmcnt(0) lgkmcnt(0)" ::: "memory"); __builtin_amdgcn_s_barrier(); asm volatile("" ::: "memory");
    const int g = wid >> 1, h = kvh * 4 + g;
    LAS float* wsf = wsfAll + wid * 128; const LAS float* bT = biasT + g * 512;
    const float sinkl = sink[h] * LOG2E;
    const int q0b = (wid & 1) * 64;
    bf16x8 qr[2][4]; float m_run[2], l_run[2]; f32x16 o0[2], o1[2];
#pragma unroll
    for (int qq = 0; qq < 2; ++qq) {
        const bf16_t* qp = QKV + (rowb + 128 * n + q0b + 32 * qq + r32) * 768 + h * 64 + hi * 8;
#pragma unroll
        for (int d0 = 0; d0 < 4; ++d0) qr[qq][d0] = *(const bf16x8*)(qp + d0 * 16);
        m_run[qq] = sinkl; l_run[qq] = hi ? 0.f : 1.f;
#pragma unroll
        for (int r = 0; r < 16; ++r) { o0[qq][r] = 0.f; o1[qq][r] = 0.f; }
    }
    int t0 = q0b >> 6, t1 = (287 + q0b) >> 6; t0 = t0 < tlo ? tlo : t0; t1 = t1 > thi ? thi : t1;
    for (int t = t0; t <= t1; ++t) {
        f32x16 p0[2], p1[2];
#pragma unroll
        for (int qq = 0; qq < 2; ++qq)
#pragma unroll
            for (int r = 0; r < 16; ++r) { p0[qq][r] = 0.f; p1[qq][r] = 0.f; }
        const LAS unsigned char* kb = ring + LDS_K + t * 8192 + hi * 1024 + r32 * 16;
#pragma unroll
        for (int d0 = 0; d0 < 4; ++d0) { const bf16x8 k0 = *(const LAS bf16x8*)(kb + d0 * 2048), k1 = *(const LAS bf16x8*)(kb + d0 * 2048 + 512);
#pragma unroll
            for (int qq = 0; qq < 2; ++qq) { p0[qq] = __builtin_amdgcn_mfma_f32_32x32x16_bf16(k0, qr[qq][d0], p0[qq], 0, 0, 0); p1[qq] = __builtin_amdgcn_mfma_f32_32x32x16_bf16(k1, qr[qq][d0], p1[qq], 0, 0, 0); } }
        u32x4 pw[2][4];
#pragma unroll
        for (int qq = 0; qq < 2; ++qq) {
            const int qpos = 128 + q0b + 32 * qq + r32;
            const LAS float* bp = bT + (64 * t - qpos + 256 + 4 * hi);
            float tm = -INFINITY;
#pragma unroll
            for (int r = 0; r < 16; ++r) { const int o = (r & 3) + 8 * (r >> 2);
                p0[qq][r] += bp[o]; p1[qq][r] += bp[o + 32];
                tm = fmaxf(tm, fmaxf(p0[qq][r], p1[qq][r])); }
            tm = fmaxf(tm, __shfl_xor(tm, 32));
            const float mn = fmaxf(m_run[qq], tm), alpha = __builtin_amdgcn_exp2f(m_run[qq] - mn); m_run[qq] = mn;
            float rs = 0.f;
#pragma unroll
            for (int r = 0; r < 16; ++r) { p0[qq][r] = __builtin_amdgcn_exp2f(p0[qq][r] - mn); p1[qq][r] = __builtin_amdgcn_exp2f(p1[qq][r] - mn); rs += p0[qq][r] + p1[qq][r]; }
            l_run[qq] = l_run[qq] * alpha + rs;
            if (__any(alpha != 1.0f)) {
                if (hi == 0) wsf[32 * qq + r32] = alpha;
                asm volatile("s_waitcnt lgkmcnt(0)" ::: "memory");
#pragma unroll
                for (int r = 0; r < 16; ++r) { const float a = wsf[32 * qq + crow(r, hi)]; o0[qq][r] *= a; o1[qq][r] *= a; }
            }
            pw[qq][0] = (u32x4){cvtpk(p0[qq][0], p0[qq][1]), cvtpk(p0[qq][2], p0[qq][3]), cvtpk(p0[qq][4], p0[qq][5]), cvtpk(p0[qq][6], p0[qq][7])};
            pw[qq][1] = (u32x4){cvtpk(p0[qq][8], p0[qq][9]), cvtpk(p0[qq][10], p0[qq][11]), cvtpk(p0[qq][12], p0[qq][13]), cvtpk(p0[qq][14], p0[qq][15])};
            pw[qq][2] = (u32x4){cvtpk(p1[qq][0], p1[qq][1]), cvtpk(p1[qq][2], p1[qq][3]), cvtpk(p1[qq][4], p1[qq][5]), cvtpk(p1[qq][6], p1[qq][7])};
            pw[qq][3] = (u32x4){cvtpk(p1[qq][8], p1[qq][9]), cvtpk(p1[qq][10], p1[qq][11]), cvtpk(p1[qq][12], p1[qq][13]), cvtpk(p1[qq][14], p1[qq][15])};
        }
        const LAS unsigned char* vb = ring + LDS_V + t * 8192 + ((lane >> 4) & 1) * 32 + (lane & 3) * 8 + (4 * hi + ((lane & 15) >> 2)) * 64;
#pragma unroll
        for (int ks = 0; ks < 4; ++ks) {
            const s16x4 l0 = vtr(vb + ks * 1024), h0 = vtr(vb + ks * 1024 + 512), l1 = vtr(vb + 4096 + ks * 1024), h1 = vtr(vb + 4096 + ks * 1024 + 512);
            const bf16x8 v0 = (bf16x8){l0[0], l0[1], l0[2], l0[3], h0[0], h0[1], h0[2], h0[3]}, v1 = (bf16x8){l1[0], l1[1], l1[2], l1[3], h1[0], h1[1], h1[2], h1[3]};
#pragma unroll
            for (int qq = 0; qq < 2; ++qq) { const bf16x8 pa = __builtin_bit_cast(bf16x8, pw[qq][ks]);
                o0[qq] = __builtin_amdgcn_mfma_f32_32x32x16_bf16(pa, v0, o0[qq], 0, 0, 0); o1[qq] = __builtin_amdgcn_mfma_f32_32x32x16_bf16(pa, v1, o1[qq], 0, 0, 0); }
        }
    }
#pragma unroll
    for (int qq = 0; qq < 2; ++qq) {
        const int q0 = q0b + 32 * qq;
        const float lt = l_run[qq] + __shfl_xor(l_run[qq], 32);
        if (hi == 0) wsf[64 + 32 * qq + r32] = lt;
        asm volatile("s_waitcnt lgkmcnt(0)" ::: "memory");
        LAS unsigned short* stg = (LAS unsigned short*)(ring + LDS_OST + wid * 4096);
#pragma unroll
        for (int r = 0; r < 16; ++r) { const int orow = crow(r, hi); const float rli = __builtin_amdgcn_rcpf(wsf[64 + 32 * qq + orow]);
            stg[orow * 64 + r32] = f2bf(o0[qq][r] * rli); stg[orow * 64 + 32 + r32] = f2bf(o1[qq][r] * rli); }
        asm volatile("s_waitcnt lgkmcnt(0)" ::: "memory");
#pragma unroll
        for (int i = 0; i < 4; ++i) { const int row = i * 8 + (lane >> 3), ch = lane & 7; const u32x4 v = *(const LAS u32x4*)(stg + row * 64 + ch * 8);
            st16(AOPQ + (rowb + 128 * n + q0 + row) * KAB + h * 64 + ch * 8, v); }
        asm volatile("s_waitcnt lgkmcnt(0)" ::: "memory");
    }
}
}

constexpr size_t MiB = 1u << 20;
constexpr size_t WS_CTL = 0, CTL_ZERO_BYTES = 64 * 1024;
constexpr size_t WS_RS = 256 * 1024;
constexpr size_t RS_BYTES = (size_t)MTOK * 4 * 4;
constexpr size_t WS_WUP1 = 2 * MiB;
constexpr size_t WS_WDN1 = WS_WUP1 + 11 * MiB;
constexpr size_t WS_WIN = WS_WDN1 + 11 * MiB / 2;
constexpr size_t WS_WAB = WS_WIN + 13 * MiB / 2;
constexpr size_t WS_WO = WS_WAB + 3 * MiB;
constexpr size_t WS_WUP2 = WS_WO + 2 * MiB;
constexpr size_t WS_WDN2 = WS_WUP2 + 11 * MiB;
constexpr size_t WS_TM = WS_WDN2 + 11 * MiB / 2;
constexpr size_t WS_SLAB0 = WS_TM + 16 * MiB;
constexpr size_t WS_XB = WS_SLAB0, WS_AFF = WS_SLAB0 + 4 * MiB, WS_QKV = WS_SLAB0 + 4 * MiB, WS_FT = WS_SLAB0 + 7 * MiB, WS_GATES = WS_SLAB0 + 9 * MiB, WS_AOPQ = WS_SLAB0 + 17 * MiB;
constexpr size_t WS_END = WS_SLAB0 + 8 * SLAB;
static_assert(WS_END <= 256 * MiB && WS_RS + 4 * RS_BYTES <= WS_WUP1, "d_ws map");
static_assert((size_t)SEQ * DM * 2 == 4 * MiB && (size_t)SEQ * DFF * 2 == 11 * MiB && (size_t)SEQ * 768 * 2 == 3 * MiB && (size_t)512 * SEQ * 2 == 2 * MiB && (size_t)SEQ * 2048 * 2 == 8 * MiB && (size_t)SEQ * KAB * 2 == 6 * MiB, "slab pieces");

constexpr int RING_BYTES = 131072, LDSCTL_OFF = RING_BYTES, MISC_OFF = LDSCTL_OFF + 320, BIAS_OFF = LDSCTL_OFF + 512, WSF_OFF = BIAS_OFF + 4 * 512 * 4, LDS_BYTES = 147456;
static_assert(WSF_OFF + 8 * 128 * 4 <= LDS_BYTES, "LDS map");

#define XB_TMO      128
#define XB_XCNT(j)  (256  + 64 * (j))
#define XB_XSUB(j)  (1280 + 64 * (j))
#define XB_XGEN(j)  (2304 + 64 * (j))
#define XB_TOP      3328
#define XB_TOPGEN   3392
#define XCD_BAR_WORDS 3456
#define XB_SPIN_CAP (1u << 18)
__device__ __forceinline__ unsigned xb_ld(unsigned* p)              { return __hip_atomic_load(p, __ATOMIC_RELAXED, __HIP_MEMORY_SCOPE_AGENT); }
__device__ __forceinline__ unsigned xb_add(unsigned* p, unsigned v) { return __hip_atomic_fetch_add(p, v, __ATOMIC_RELAXED, __HIP_MEMORY_SCOPE_AGENT); }
__device__ __forceinline__ unsigned xb_xcc_id() { return (unsigned)__builtin_amdgcn_s_getreg((3 << 11) | 20) & 0xFu; }
#define XB_SPIN(cond, bar) do { unsigned _sp = 0; while (cond) { __builtin_amdgcn_s_sleep(1); \
    if ((++_sp & 255u) == 0u) { if (xb_ld(&(bar)[XB_TMO])) break; if (_sp > XB_SPIN_CAP) { atomicAdd(&(bar)[XB_TMO], 1u); break; } } } } while (0)
struct XcdBarrier { unsigned* bar; unsigned x; volatile LAS unsigned* st; };
__device__ __forceinline__ XcdBarrier xcd_barrier_post(unsigned* bar, volatile LAS unsigned* st) {
    XcdBarrier b; b.bar = bar; b.x = xb_xcc_id(); b.st = st;
    if (threadIdx.x == 0) (void)xb_add(&bar[XB_XCNT(b.x)], 1u);
    return b;
}
__device__ __forceinline__ void xcd_barrier_complete(unsigned* bar, unsigned x, unsigned& nloc, unsigned& nx) {
    const unsigned G = gridDim.x * gridDim.y * gridDim.z;
    unsigned sum, cnt, mine, sp = 0u;
    for (;;) {
        sum = 0u; cnt = 0u; mine = 0u;
#pragma unroll
        for (unsigned j = 0; j < 16; ++j) { const unsigned c = xb_ld(&bar[XB_XCNT(j)]); sum += c; cnt += (c > 0u) ? 1u : 0u; mine = (j == x) ? c : mine; }
        if (sum == G) break;
        __builtin_amdgcn_s_sleep(1);
        if ((++sp & 255u) == 0u) { if (xb_ld(&bar[XB_TMO])) break; if (sp > XB_SPIN_CAP) { atomicAdd(&bar[XB_TMO], 1u); break; } }
    }
    nloc = mine > 0u ? mine : 1u; nx = cnt > 0u ? cnt : 1u;
}
__device__ __forceinline__ void xcd_barrier(const XcdBarrier& b) {
    asm volatile("s_waitcnt vmcnt(0)" ::: "memory");
    __syncthreads();
    if (threadIdx.x == 0) {
        unsigned* bar = b.bar;
        __builtin_amdgcn_s_waitcnt(0);
        unsigned nloc = b.st[0], nx = b.st[1];
        if (nloc == 0u) { xcd_barrier_complete(bar, b.x, nloc, nx); b.st[0] = nloc; b.st[1] = nx; }
        const unsigned old = xb_add(&bar[XB_XSUB(b.x)], 1u);
        const unsigned gen = old / nloc;
        if (old + 1u == (gen + 1u) * nloc) {
            __builtin_amdgcn_fence(__ATOMIC_RELEASE, "agent");
            asm volatile("s_waitcnt vmcnt(0)" ::: "memory");
            const unsigned og = xb_add(&bar[XB_TOP], 1u);
            const unsigned tg = og / nx;
            if (og + 1u == (tg + 1u) * nx) xb_add(&bar[XB_TOPGEN], 1u);
            else XB_SPIN(xb_ld(&bar[XB_TOPGEN]) == tg, bar);
            __builtin_amdgcn_fence(__ATOMIC_ACQUIRE, "agent");
            xb_add(&bar[XB_XGEN(b.x)], 1u);
            asm volatile("s_waitcnt vmcnt(0)" ::: "memory");
        } else {
            XB_SPIN(xb_ld(&bar[XB_XGEN(b.x)]) == gen, bar);
            __builtin_amdgcn_fence(__ATOMIC_ACQUIRE, "agent");
            asm volatile("s_waitcnt vmcnt(0)" ::: "memory");
        }
    }
    __syncthreads();
}


__device__ __forceinline__ void group_barrier(unsigned* cnt, unsigned target, bool pure, unsigned* tmo) {
    asm volatile("s_waitcnt vmcnt(0)" ::: "memory");
    __syncthreads();
    if (threadIdx.x == 0) {
        if (!pure) { __builtin_amdgcn_fence(__ATOMIC_RELEASE, "agent"); asm volatile("s_waitcnt vmcnt(0)" ::: "memory"); }
        (void)xb_add(cnt, 1u);
        unsigned sp = 0u;
        while (xb_ld(cnt) < target) { __builtin_amdgcn_s_sleep(1); if ((++sp & 255u) == 0u) { if (xb_ld(tmo)) break; if (sp > XB_SPIN_CAP) { atomicAdd(tmo, 1u); break; } } }
        __builtin_amdgcn_fence(__ATOMIC_ACQUIRE, "agent");
        asm volatile("s_waitcnt vmcnt(0)" ::: "memory");
    }
    __syncthreads();
}


struct EpiFinal {
    static constexpr bool AFTER_DRAIN = true; static constexpr int MID_T = -1;
    const bf16_t* XB; float* out; float* RSo; const float* gfin; float alpha; unsigned* cnt; unsigned target; bool pure; unsigned* tmo;
    __device__ __forceinline__ void mid(Acc&, const Unit&, int, int, int, int) const {}
    __device__ __forceinline__ void operator()(const Acc&, const Unit&, int, int, int, int) const {}
    __device__ __forceinline__ void fused(Acc& acc, const Unit& u, int wr, int wc, int fr, int fq, LAS unsigned char* lds, int wid, int lane) const {
        asm volatile("" : "+v"(fr), "+v"(fq));
        LAS float* P = (LAS float*)lds;
#pragma unroll
        for (int ai = 0; ai < 2; ++ai) {
            u32x4 xr[4][2];
#pragma unroll
            for (int m = 0; m < 4; ++m)
#pragma unroll
                for (int bj = 0; bj < 2; ++bj) xr[m][bj] = *(const u32x4*)(brow(XB, u.pm * 256 + ai * 128 + wr * 64 + m * 16 + fr, DM) + u.pn * 256 + bj * 128 + wc * 32 + 8 * fq);
#pragma unroll
            for (int m = 0; m < 4; ++m) {
                const int rl = ai * 128 + wr * 64 + m * 16 + fr, row = u.pm * 256 + rl; float ss = 0.f;
#pragma unroll
                for (int bj = 0; bj < 2; ++bj) {
                    f32x4 x0, x1; unpack8(xr[m][bj], x0, x1);
                    x0 = x0 + acc[ai][bj][m][0] * alpha; x1 = x1 + acc[ai][bj][m][1] * alpha;
                    acc[ai][bj][m][0] = x0; acc[ai][bj][m][1] = x1;
                    ss += (x0[0] * x0[0] + x0[1] * x0[1]) + (x0[2] * x0[2] + x0[3] * x0[3]) + (x1[0] * x1[0] + x1[1] * x1[1]) + (x1[2] * x1[2] + x1[3] * x1[3]);
                }
                ss += __shfl_xor(ss, 16); ss += __shfl_xor(ss, 32);
                if (fq == 0) P[rl * 4 + wc] = ss;
            }
        }
        asm volatile("s_waitcnt lgkmcnt(0)" ::: "memory"); __builtin_amdgcn_s_barrier(); asm volatile("" ::: "memory");
        const int tid = wid * 64 + lane;
        if (tid < 256) { const f32x4 p = *(const LAS f32x4*)(P + tid * 4); RSo[(size_t)(u.pm * 256 + tid) * 4 + u.pn] = (p[0] + p[1]) + (p[2] + p[3]); }
        group_barrier(cnt, target, pure, tmo);
        asm volatile("" : "+v"(fr), "+v"(fq));
        f32x4 gv[2][2];
#pragma unroll
        for (int bj = 0; bj < 2; ++bj)
#pragma unroll
            for (int n = 0; n < 2; ++n) gv[bj][n] = *(const f32x4*)(gfin + u.pn * 256 + bj * 128 + wc * 32 + 8 * fq + 4 * n);
        float rv[2][4];
#pragma unroll
        for (int ai = 0; ai < 2; ++ai)
#pragma unroll
            for (int m = 0; m < 4; ++m) rv[ai][m] = row_rinv(RSo, u.pm * 256 + ai * 128 + wr * 64 + m * 16 + fr);
#pragma unroll
        for (int ai = 0; ai < 2; ++ai)
#pragma unroll
            for (int m = 0; m < 4; ++m) {
                const int row = u.pm * 256 + ai * 128 + wr * 64 + m * 16 + fr; const float r = rv[ai][m];
#pragma unroll
                for (int bj = 0; bj < 2; ++bj) { const size_t off = (size_t)row * DM + u.pn * 256 + bj * 128 + wc * 32 + 8 * fq;
                    st16f(out + off, acc[ai][bj][m][0] * gv[bj][0] * r); st16f(out + off + 4, acc[ai][bj][m][1] * gv[bj][1] * r); }
            }
    }
};

__device__ __forceinline__ float wave_sum(float v) {
#pragma unroll
    for (int o = 1; o < 64; o <<= 1) v += __shfl_xor(v, o);
    return v;
}
__device__ __forceinline__ void transpose_item(const float* W, int ldsrc, int srccol0, int k0, const float* gk, float cs, bf16_t* WT, int ldd, int drow0, LAS float* scr, int lane) {
#pragma unroll 8
    for (int i = 0; i < 32; ++i) { const int kk = 2 * i + (lane >> 5); float v = W[(size_t)(k0 + kk) * ldsrc + srccol0 + (lane & 31)]; if (gk) v *= gk[k0 + kk]; scr[kk * 33 + (lane & 31)] = v * cs; }
    asm volatile("s_waitcnt lgkmcnt(0)" ::: "memory");
    const int c = lane & 7;
#pragma unroll
    for (int j = 0; j < 4; ++j) { const int n = (lane >> 3) + 8 * j; const LAS float* s = scr + (8 * c) * 33 + n;
        u32x4 o; o.x = cvtpk(s[0 * 33], s[1 * 33]); o.y = cvtpk(s[2 * 33], s[3 * 33]); o.z = cvtpk(s[4 * 33], s[5 * 33]); o.w = cvtpk(s[6 * 33], s[7 * 33]);
        *(u32x4*)(WT + (size_t)(drow0 + n) * ldd + k0 + 8 * c) = o; }
    asm volatile("s_waitcnt lgkmcnt(0)" ::: "memory");
}
__device__ __forceinline__ int map_up(int rho) { const int pn = rho >> 8, i = rho & 255; return i < 128 ? 128 * pn + i : DFF + 128 * pn + (i - 128); }
__device__ __forceinline__ int map_in(int rho) { if (rho < 1280) return rho; const int t = (rho - 1280) >> 8, i = (rho - 1280) & 255; return i < 128 ? 1280 + 128 * t + i : 2304 + 128 * t + (i - 128); }

struct Args { const float* in[16]; float* out; unsigned char* ws; };

__global__ void __launch_bounds__(512, 2) mega_fwd(Args args) {
    extern __shared__ __attribute__((aligned(16))) unsigned char lds_raw[];
    LAS unsigned char* lds = (LAS unsigned char*)lds_raw;
    volatile LAS unsigned* MISC = (volatile LAS unsigned*)(lds + MISC_OFF);
    const int tid = threadIdx.x, lane = tid & 63, wave = __builtin_amdgcn_readfirstlane(tid >> 6);
    const int G = gridDim.x, bx = blockIdx.x;
    const int vcu = (G % 8 == 0) ? (bx % 8) * (G / 8) + bx / 8 : bx;
    unsigned char* ws = args.ws;
    unsigned* ctl = (unsigned*)(ws + WS_CTL);
    const float* x = args.in[0]; const float* g_ffn1 = args.in[1]; const float* w_up1 = args.in[2]; const float* w_dn1 = args.in[3]; const float* g_mix = args.in[4]; const float* w_in = args.in[5];
    const float* b_gate = args.in[6]; const float* sink = args.in[7]; const float* rel_bias = args.in[8]; const float* w_a = args.in[9]; const float* w_b = args.in[10]; const float* w_o = args.in[11];
    const float* g_ffn2 = args.in[12]; const float* w_up2 = args.in[13]; const float* w_dn2 = args.in[14]; const float* g_final = args.in[15];
    float* out = args.out;
    bf16_t* Wup1 = (bf16_t*)(ws + WS_WUP1); bf16_t* Wdn1 = (bf16_t*)(ws + WS_WDN1); bf16_t* Win = (bf16_t*)(ws + WS_WIN); bf16_t* Wab = (bf16_t*)(ws + WS_WAB); bf16_t* Wo = (bf16_t*)(ws + WS_WO);
    bf16_t* Wup2 = (bf16_t*)(ws + WS_WUP2); bf16_t* Wdn2 = (bf16_t*)(ws + WS_WDN2); bf16_t* Tm = (bf16_t*)(ws + WS_TM); bf16_t* XB = (bf16_t*)(ws + WS_XB);
    bf16_t* AFF = (bf16_t*)(ws + WS_AFF); bf16_t* QKV = (bf16_t*)(ws + WS_QKV); bf16_t* FT = (bf16_t*)(ws + WS_FT); bf16_t* GATES = (bf16_t*)(ws + WS_GATES); bf16_t* AOPQ = (bf16_t*)(ws + WS_AOPQ);
    float* RS0 = (float*)(ws + WS_RS); float* RS1 = (float*)(ws + WS_RS + RS_BYTES); float* RS2 = (float*)(ws + WS_RS + 2 * RS_BYTES); float* RS3 = (float*)(ws + WS_RS + 3 * RS_BYTES);

    for (int u = tid; u < (LDS_BYTES - LDSCTL_OFF) / 4; u += 512) ((LAS unsigned*)(lds + LDSCTL_OFF))[u] = 0u;
    __syncthreads();
    if (PROBE_K >= 0 && bx == 0 && tid == 0) { const unsigned long long t_ = __builtin_amdgcn_s_memrealtime(); MISC[18] = (unsigned)t_; MISC[19] = (unsigned)(t_ >> 32); }
    XcdBarrier bar = xcd_barrier_post(ctl + 1024, MISC + 8);
    unsigned* grp_cnt = ctl + 8192 + 64 * (bx & 7); unsigned* grp_census = ctl + 6144 + 16 * (bx & 7); unsigned grp_gen = 0u; bool grp_pure = false;
    if (tid == 0) (void)xb_add(grp_census + (bar.x & 15u), 1u);
#define GRID_BAR() xcd_barrier(bar)
#define STAMP(k) do { if ((k) == PROBE_K && bx == 0 && tid == 0) { const unsigned long long t_ = __builtin_amdgcn_s_memrealtime(); MISC[16] = (unsigned)t_; MISC[17] = (unsigned)(t_ >> 32); } } while (0)
#define GROUP_BAR() do { ++grp_gen; group_barrier(grp_cnt, grp_gen * (unsigned)(G / 8), grp_pure, ctl + 1024 + XB_TMO); } while (0)
#ifndef REPEAT
#define REPEAT -1
#endif
#ifndef NREP
#define NREP 2
#endif
#define PH(n) for (int rep_ = 0; rep_ < ((n) == REPEAT ? NREP : 1); ++rep_)

    constexpr int I_UP = 16 * (NUP / 32), I_DN = (DFF / 64) * (DM / 32), I_IN = 16 * (INW / 32), I_A = 8 * 32, I_O = 16 * 32;
    constexpr int NITEMS = 2 * I_UP + 2 * I_DN + I_IN + I_A + I_O;
    LAS float* cosT = (LAS float*)(lds + 8 * 8448);
    auto p0_transposes = [&](const int IT0, const int IT1, const int GW_, const int NGW_) {
        {
            LAS float* scr = (LAS float*)(lds + wave * 8448);
            const int kr = lane >> 3, c4 = lane & 7;
            struct TI { const float* src; const float* gk; bf16_t* dst; int ldsrc, ldd, k0; float cs; };
            auto decode = [&](int it, TI& t) {
                int r = it;
                if (r < 2 * I_UP) { const int second = r >= I_UP; if (second) r -= I_UP; const int nb = r % (NUP / 32), kb = r / (NUP / 32);
                    t.src = (second ? w_up2 : w_up1) + map_up(32 * nb); t.ldsrc = NUP; t.gk = second ? g_ffn2 : g_ffn1; t.cs = 1.0f; t.dst = (second ? Wup2 : Wup1) + (size_t)(32 * nb) * DM; t.ldd = DM; t.k0 = 64 * kb; return; }
                r -= 2 * I_UP;
                if (r < 2 * I_DN) { const int second = r >= I_DN; if (second) r -= I_DN; const int nb = r % 32, kb = r / 32;
                    t.src = (second ? w_dn2 : w_dn1) + 32 * nb; t.ldsrc = DM; t.gk = nullptr; t.cs = 1.0f; t.dst = (second ? Wdn2 : Wdn1) + (size_t)(32 * nb) * DFF; t.ldd = DFF; t.k0 = 64 * kb; return; }
                r -= 2 * I_DN;
                if (r < I_IN) { const int nb = r % (INW / 32), kb = r / (INW / 32);
                    t.src = w_in + map_in(32 * nb); t.ldsrc = INW; t.gk = g_mix; t.cs = (32 * nb < 512) ? QSCALE : 1.0f; t.dst = Win + (size_t)(32 * nb) * DM; t.ldd = DM; t.k0 = 64 * kb; return; }
                r -= I_IN;
                if (r < I_A) { const int nb = r % 32, kb = r / 32; t.src = w_a + 32 * nb; t.ldsrc = DM; t.gk = nullptr; t.cs = 1.0f; t.dst = Wab + (size_t)(32 * nb) * KAB; t.ldd = KAB; t.k0 = 64 * kb; return; }
                r -= I_A;
                { const int nb = r % 32, kb = r / 32; t.src = w_o + 32 * nb; t.ldsrc = DM; t.gk = nullptr; t.cs = 1.0f; t.dst = Wo + (size_t)(32 * nb) * DM; t.ldd = DM; t.k0 = 64 * kb; }
            };
            f32x4 cur[8], nxt[8]; float gc[8], gn[8];
            TI tc, tn;
            int it = IT0 + GW_;
            if (it < IT1) { decode(it, tc);
#pragma unroll
                for (int i = 0; i < 8; ++i) { const int k = tc.k0 + 8 * i + kr; cur[i] = *(const f32x4*)(tc.src + (size_t)k * tc.ldsrc + 4 * c4); gc[i] = tc.gk ? tc.gk[k] : 1.0f; } }
            while (it < IT1) {
                const int itn = it + NGW_; const bool hn = itn < IT1;
                if (hn) { decode(itn, tn);
#pragma unroll
                    for (int i = 0; i < 8; ++i) { const int k = tn.k0 + 8 * i + kr; nxt[i] = *(const f32x4*)(tn.src + (size_t)k * tn.ldsrc + 4 * c4); gn[i] = tn.gk ? tn.gk[k] : 1.0f; } }
#pragma unroll
                for (int i = 0; i < 8; ++i) { const float sc = gc[i] * tc.cs; LAS float* p = scr + (8 * i + kr) * 33 + 4 * c4; p[0] = cur[i][0] * sc; p[1] = cur[i][1] * sc; p[2] = cur[i][2] * sc; p[3] = cur[i][3] * sc; }
                asm volatile("s_waitcnt lgkmcnt(0)" ::: "memory");
                { const int c = lane & 7;
#pragma unroll
                  for (int j = 0; j < 4; ++j) { const int n = (lane >> 3) + 8 * j; const LAS float* s = scr + (8 * c) * 33 + n;
                      u32x4 o; o.x = cvtpk(s[0 * 33], s[1 * 33]); o.y = cvtpk(s[2 * 33], s[3 * 33]); o.z = cvtpk(s[4 * 33], s[5 * 33]); o.w = cvtpk(s[6 * 33], s[7 * 33]);
                      st16(tc.dst + (size_t)n * tc.ldd + tc.k0 + 8 * c, o); } }
                asm volatile("s_waitcnt lgkmcnt(0)" ::: "memory");
                if (hn) { tc = tn;
#pragma unroll
                    for (int i = 0; i < 8; ++i) { cur[i] = nxt[i]; gc[i] = gn[i]; } }
                it = itn;
            }
        }
    };
    auto p0_xb = [&](const int GW_, const int NGW_) {
        {
            f32x4 v[4], w[4]; int m = GW_;
            if (m < MTOK) { const f32x4* xr = (const f32x4*)(x + (size_t)m * DM) + 2 * lane;
#pragma unroll
                for (int j = 0; j < 2; ++j) { v[2 * j] = xr[128 * j]; v[2 * j + 1] = xr[128 * j + 1]; } }
            while (m < MTOK) {
                const int mn = m + NGW_;
                if (mn < MTOK) { const f32x4* xr = (const f32x4*)(x + (size_t)mn * DM) + 2 * lane;
#pragma unroll
                    for (int j = 0; j < 2; ++j) { w[2 * j] = xr[128 * j]; w[2 * j + 1] = xr[128 * j + 1]; } }
                float s = 0.f;
#pragma unroll
                for (int j = 0; j < 4; ++j) s += (v[j][0] * v[j][0] + v[j][1] * v[j][1]) + (v[j][2] * v[j][2] + v[j][3] * v[j][3]);
                s = wave_sum(s);
#pragma unroll
                for (int j = 0; j < 2; ++j) st16(brow(XB, m, DM) + 512 * j + 8 * lane, pack8(v[2 * j], v[2 * j + 1]));
                if (lane == 0) *(f32x4*)(RS0 + (size_t)m * 4) = (f32x4){s, 0.f, 0.f, 0.f};
#pragma unroll
                for (int j = 0; j < 4; ++j) v[j] = w[j];
                m = mn;
            }
        }
    };
    auto p0_fold_tm = [&](const int GW_, const int NGW_) {
        {
            LAS float* tab = (LAS float*)(lds + 8 * 8448 + 8192 + wave * 4096);
            for (int item = GW_; item < 2048; item += NGW_) {
                const int kg = item >> 4, ng = item & 15, g = kg >> 5, j0 = (8 * kg) & 255, part = j0 >> 7, c0 = j0 & 127, n = 64 * ng + lane;
#pragma unroll
                for (int i = 0; i < 16; ++i) { const int idx = lane + 64 * i, cp = idx >> 3, e = idx & 7, ph = ((c0 + e) * cp) & 127; tab[idx] = part ? -cosT[(16 * ph - 512) & 2047] : cosT[16 * ph]; }
                asm volatile("s_waitcnt lgkmcnt(0)" ::: "memory");
                float a8[8];
#pragma unroll
                for (int e = 0; e < 8; ++e) a8[e] = 0.f;
                const float* wp = w_b + (size_t)(g * 128) * DM + n;
                float wa[16], wb[16];
#pragma unroll
                for (int i = 0; i < 16; ++i) wa[i] = wp[(size_t)i * DM];
#pragma unroll 1
                for (int cb = 0; cb < 128; cb += 32) {
#pragma unroll
                    for (int i = 0; i < 16; ++i) wb[i] = wp[(size_t)(cb + 16 + i) * DM];
#pragma unroll
                    for (int i = 0; i < 16; ++i) { const int cp = cb + i; const float w = wa[i]; const f32x4 t0 = *(const LAS f32x4*)(tab + cp * 8), t1 = *(const LAS f32x4*)(tab + cp * 8 + 4);
                        a8[0] += w * t0[0]; a8[1] += w * t0[1]; a8[2] += w * t0[2]; a8[3] += w * t0[3]; a8[4] += w * t1[0]; a8[5] += w * t1[1]; a8[6] += w * t1[2]; a8[7] += w * t1[3];
                        if ((i & 3) == 3) asm volatile("" : "+v"(a8[0]), "+v"(a8[1]), "+v"(a8[2]), "+v"(a8[3]), "+v"(a8[4]), "+v"(a8[5]), "+v"(a8[6]), "+v"(a8[7])); }
                    if (cb + 32 < 128) {
#pragma unroll
                        for (int i = 0; i < 16; ++i) wa[i] = wp[(size_t)(cb + 32 + i) * DM]; }
#pragma unroll
                    for (int i = 0; i < 16; ++i) { const int cp = cb + 16 + i; const float w = wb[i]; const f32x4 t0 = *(const LAS f32x4*)(tab + cp * 8), t1 = *(const LAS f32x4*)(tab + cp * 8 + 4);
                        a8[0] += w * t0[0]; a8[1] += w * t0[1]; a8[2] += w * t0[2]; a8[3] += w * t0[3]; a8[4] += w * t1[0]; a8[5] += w * t1[1]; a8[6] += w * t1[2]; a8[7] += w * t1[3];
                        if ((i & 3) == 3) asm volatile("" : "+v"(a8[0]), "+v"(a8[1]), "+v"(a8[2]), "+v"(a8[3]), "+v"(a8[4]), "+v"(a8[5]), "+v"(a8[6]), "+v"(a8[7])); }
                }
                const float sc = 0.08838834764831845f;
                u32x4 o; o.x = cvtpk(a8[0] * sc, a8[1] * sc); o.y = cvtpk(a8[2] * sc, a8[3] * sc); o.z = cvtpk(a8[4] * sc, a8[5] * sc); o.w = cvtpk(a8[6] * sc, a8[7] * sc);
                st16(Wab + (size_t)n * KAB + 512 + 8 * kg, o);
                asm volatile("s_waitcnt lgkmcnt(0)" ::: "memory");
            }
        }
    };
    auto p0_tm = [&](const int GW_, const int NGW_) {
        for (int idx = GW_ * 64 + lane; idx < 2048 * 256; idx += NGW_ * 64) {
            const int rT = idx >> 8, s0 = (idx & 255) * 8, part = rT >> 10, k = (rT == 1024) ? 1024 : (rT & 1023); const float sc = 0.022097086912079608f;
            float v[8];
#pragma unroll
            for (int e = 0; e < 8; ++e) { const int ph = (k * (s0 + e)) & 2047; v[e] = cosT[(part && rT != 1024) ? ((ph - 512) & 2047) : ph] * sc; }
            u32x4 o; o.x = cvtpk(v[0], v[1]); o.y = cvtpk(v[2], v[3]); o.z = cvtpk(v[4], v[5]); o.w = cvtpk(v[6], v[7]);
            st16(Tm + (size_t)rT * SEQ + s0, o);
        }
    };
    PH(0) {
        const int gw = vcu * 8 + wave, NGW = G * 8;
        for (int j = tid; j < 2048; j += 512) cosT[j] = cospif((float)j * (1.0f / 1024.0f));
        __syncthreads();
        if (wave & 1) p0_fold_tm(gw, NGW);
        p0_xb(gw, NGW);
        p0_transposes(0, I_UP, gw, NGW);
        if (!(wave & 1)) p0_fold_tm(gw, NGW);
        __syncthreads();
    }
    GRID_BAR(); STAMP(1);
    grp_pure = (G % 8 == 0) && (xb_ld(grp_census + (bar.x & 15u)) == (unsigned)(G / 8));

    PH(1) { SchedPlain S; S.T.init(MTOK, NUP, G, bx); S.A = (const char*)XB; S.Bt = (const char*)Wup1; S.tA = (size_t)256 * DM * 2; S.tB = (size_t)256 * DM * 2;
      EpiSwiGLU E{RS0, AFF}; pg8::gemm_phase<EpiSwiGLU, SchedPlain, true>(lds, pg8::GemmP{DM, DM, DM}, S, E); }
    if (2 * bx >= G) {
        const int gw = (bx - G / 2) * 8 + wave, NGW = (G - G / 2) * 8;
        for (int j = tid; j < 2048; j += 512) cosT[j] = cospif((float)j * (1.0f / 1024.0f));
        __syncthreads();
        p0_transposes(I_UP, NITEMS, gw, NGW);
        p0_tm(gw, NGW);
        __syncthreads();
    }
    GRID_BAR(); STAMP(2);
    PH(2) { SchedPlain S; S.T.init(MTOK, DM, G, bx); S.A = (const char*)AFF; S.Bt = (const char*)Wdn1; S.tA = (size_t)256 * DFF * 2; S.tB = (size_t)256 * DFF * 2;
      EpiResid<true> E{x, XB, RS1, 0.5f}; pg8::gemm_phase<EpiResid<true>, SchedPlain, false>(lds, pg8::GemmP{DFF, DFF, DFF}, S, E); }
    GROUP_BAR(); STAMP(3);
    PH(3) { SchedWin S; S.T.init(MTOK, 12 * 256, G, bx); S.X = (const char*)XB; S.W = (const char*)Win; S.tX = (size_t)256 * DM * 2; S.tW = (size_t)256 * DM * 2;
      EpiWin E{RS1, b_gate, QKV, FT, GATES}; pg8::gemm_phase<EpiWin, SchedWin, true>(lds, pg8::GemmP{DM, DM, DM}, S, E); }
    GROUP_BAR(); STAMP(4);
    { const int b = bx & 7, ci = bx >> 3;
      if (ci < 16) {
        PH(41) { SchedOne S; S.u0 = Unit{ci >> 1, ci & 1}; S.A = (const char*)(Tm + (size_t)(ci >> 1) * 256 * SEQ); S.Bt = (const char*)(FT + (size_t)b * SLAB_E + (size_t)(ci & 1) * 256 * SEQ);
          EpiDft E{AOPQ, b}; pg8::gemm_phase<EpiDft, SchedOne, false>(lds, pg8::GemmP{SEQ, SEQ, SEQ}, S, E); }
      } else {
        if (ci < 24) { SchedOne S; S.u0 = Unit{8 * b + (ci - 16), 12}; S.A = (const char*)(brow(XB, (8 * b + (ci - 16)) * 256, DM)); S.Bt = (const char*)(Win + (size_t)12 * 256 * DM);
          EpiWin E{RS1, b_gate, QKV, FT, GATES}; pg8::gemm_phase<EpiWin, SchedOne, false>(lds, pg8::GemmP{DM, DM, DM}, S, E); }
        const int na = ci < 24 ? 1 : 3, a0 = ci < 24 ? ci - 16 : 8 + 3 * (ci - 24);
        PH(42) { for (int r = 0; r < na; ++r) { const int a = a0 + r;
            att::attn_unit(lds, (LAS float*)(lds + BIAS_OFF), (LAS float*)(lds + WSF_OFF), QKV, AOPQ, sink, rel_bias, b, a & 1, a >> 1);
            asm volatile("s_waitcnt lgkmcnt(0)" ::: "memory"); __builtin_amdgcn_s_barrier(); } }
      }
    }
    GROUP_BAR(); STAMP(5);
    PH(5) { SchedPlain S; S.T.init(MTOK, DM, G, bx); S.A = (const char*)AOPQ; S.Bt = (const char*)Wab; S.tA = (size_t)256 * KAB * 2; S.tB = (size_t)256 * KAB * 2;
      EpiGate E{GATES}; pg8::gemm_phase<EpiGate, SchedPlain, false>(lds, pg8::GemmP{KAB, KAB, KAB}, S, E); }
    GROUP_BAR(); STAMP(6);
    PH(6) { SchedPlain S; S.T.init(MTOK, DM, G, bx); S.A = (const char*)GATES; S.Bt = (const char*)Wo; S.tA = (size_t)256 * 2048 * 2; S.tB = (size_t)256 * DM * 2;
      EpiResid<false> E{nullptr, XB, RS2, 1.0f}; pg8::gemm_phase<EpiResid<false>, SchedPlain, false>(lds, pg8::GemmP{DM, 2048, DM}, S, E); }
    GROUP_BAR(); STAMP(7);
    PH(7) { SchedPlain S; S.T.init(MTOK, NUP, G, bx); S.A = (const char*)XB; S.Bt = (const char*)Wup2; S.tA = (size_t)256 * DM * 2; S.tB = (size_t)256 * DM * 2;
      EpiSwiGLU E{RS2, AFF}; pg8::gemm_phase<EpiSwiGLU, SchedPlain, true>(lds, pg8::GemmP{DM, DM, DM}, S, E); }
    GROUP_BAR(); STAMP(8);
    PH(8) { SchedPlain S; S.T.init(MTOK, DM, G, bx); S.A = (const char*)AFF; S.Bt = (const char*)Wdn2; S.tA = (size_t)256 * DFF * 2; S.tB = (size_t)256 * DFF * 2;
      ++grp_gen; EpiFinal E{XB, out, RS3, g_final, 0.5f, grp_cnt, grp_gen * (unsigned)(G / 8), grp_pure, ctl + 1024 + XB_TMO};
      pg8::gemm_phase<EpiFinal, SchedPlain, false>(lds, pg8::GemmP{DFF, DFF, DFF}, S, E); }
    if (PROBE_K >= 0 && bx == 0 && tid == 0) { const unsigned long long t_sel = ((unsigned long long)MISC[17] << 32) | MISC[16], t_start = ((unsigned long long)MISC[19] << 32) | MISC[18]; const unsigned long long t_end = __builtin_amdgcn_s_memrealtime(), want = 4ull * (t_sel - t_start); while (__builtin_amdgcn_s_memrealtime() - t_end < want) __builtin_amdgcn_s_sleep(8); }
}

extern "C" void kernel_launch(void* const* d_in, const int* in_sizes, int n_in, void* d_out, int out_size, void* d_ws, size_t ws_size, hipStream_t stream) {
    static int grid = 0;
    if (grid == 0) {
        if (n_in != 16 || in_sizes[0] != MTOK * DM || out_size != MTOK * DM || ws_size < WS_END) { fprintf(stderr, "kernel_launch: unexpected shapes (n_in %d, ws %zu)\n", n_in, ws_size); grid = -1; return; }
        int dev = 0, cus = 0, per_cu = 0;
        if (hipGetDevice(&dev) != hipSuccess || hipDeviceGetAttribute(&cus, hipDeviceAttributeMultiprocessorCount, dev) != hipSuccess) { grid = -1; return; }
        if (hipFuncSetAttribute((const void*)mega_fwd, hipFuncAttributeMaxDynamicSharedMemorySize, LDS_BYTES) != hipSuccess) { fprintf(stderr, "kernel_launch: hipFuncSetAttribute failed\n"); grid = -1; return; }
        if (hipOccupancyMaxActiveBlocksPerMultiprocessor(&per_cu, (const void*)mega_fwd, 512, LDS_BYTES) != hipSuccess || per_cu < 1) { fprintf(stderr, "kernel_launch: occupancy query says %d\n", per_cu); }
        (void)hipGetLastError();
        grid = cus;
        if (grid != 256) { fprintf(stderr, "kernel_launch: needs 256 CUs, device has %d\n", cus); grid = -1; return; }
    }
    if (grid < 0) return;
    if (hipMemsetAsync((char*)d_ws + WS_CTL, 0, CTL_ZERO_BYTES, stream) != hipSuccess) return;
    Args a{};
    for (int i = 0; i < 16; ++i) a.in[i] = (const float*)d_in[i];
    a.out = (float*)d_out; a.ws = (unsigned char*)d_ws;
    hipLaunchKernelGGL(mega_fwd, dim3(grid), dim3(512), LDS_BYTES, stream, a);
}
```

```cpp
#include <hip/hip_runtime.h>
#include <cstdio>
#include <cstdint>
#include <cmath>

#ifndef PROBE_K
#define PROBE_K -1
#endif
#define LAS __attribute__((address_space(3)))
#define GAS __attribute__((address_space(1)))
typedef unsigned short bf16_t;
typedef short bf16x8 __attribute__((ext_vector_type(8)));
typedef float f32x4 __attribute__((ext_vector_type(4)));
typedef float f32x16 __attribute__((ext_vector_type(16)));
typedef unsigned u32x4 __attribute__((ext_vector_type(4)));
typedef float f32x2_t __attribute__((ext_vector_type(2)));
typedef __bf16 bf16x2_t __attribute__((ext_vector_type(2)));
typedef short s16x4 __attribute__((ext_vector_type(4)));

constexpr int DM = 1024, NB = 8, SEQ = 2048, MTOK = NB * SEQ, DFF = 2816, NUP = 2 * DFF, INW = 3328;
constexpr int KAB = 1536;
constexpr float LOG2E = 1.4426950408889634f;
constexpr float QSCALE = 0.125f * LOG2E;
constexpr float RMS_EPS = 1e-6f;
constexpr size_t SLAB = (size_t)23 << 20, SLAB_E = SLAB / 2;
__device__ __forceinline__ unsigned short* brow(unsigned short* base, int row, int pitch) { return base + (size_t)(row >> 11) * SLAB_E + (size_t)(row & 2047) * pitch; }
__device__ __forceinline__ const unsigned short* brow(const unsigned short* base, int row, int pitch) { return base + (size_t)(row >> 11) * SLAB_E + (size_t)(row & 2047) * pitch; }

__device__ __forceinline__ unsigned cvtpk(float lo, float hi) { f32x2_t v = {lo, hi}; bf16x2_t b = __builtin_convertvector(v, bf16x2_t); return __builtin_bit_cast(unsigned, b); }
__device__ __forceinline__ u32x4 pack8(f32x4 a, f32x4 b) { u32x4 w; w.x = cvtpk(a[0], a[1]); w.y = cvtpk(a[2], a[3]); w.z = cvtpk(b[0], b[1]); w.w = cvtpk(b[2], b[3]); return w; }
#ifndef WT_STORES
#define WT_STORES 0
#endif
__device__ __forceinline__ void st16(void* p, u32x4 v) {
#if WT_STORES
    asm volatile("global_store_dwordx4 %0, %1, off sc1\n\ts_nop 1" :: "v"(p), "v"(v) : "memory");
#else
    *(u32x4*)p = v;
#endif
}
__device__ __forceinline__ void st16f(void* p, f32x4 v) { st16(p, __builtin_bit_cast(u32x4, v)); }
__device__ __forceinline__ void unpack8(u32x4 w, f32x4& a, f32x4& b) {
    a[0] = __builtin_bit_cast(float, w.x << 16); a[1] = __builtin_bit_cast(float, w.x & 0xffff0000u); a[2] = __builtin_bit_cast(float, w.y << 16); a[3] = __builtin_bit_cast(float, w.y & 0xffff0000u);
    b[0] = __builtin_bit_cast(float, w.z << 16); b[1] = __builtin_bit_cast(float, w.z & 0xffff0000u); b[2] = __builtin_bit_cast(float, w.w << 16); b[3] = __builtin_bit_cast(float, w.w & 0xffff0000u);
}
__device__ __forceinline__ float bf2f(unsigned short h) { return __builtin_bit_cast(float, (unsigned)h << 16); }
__device__ __forceinline__ float row_rinv(const float* RS, int row) { const f32x4 p = *(const f32x4*)(RS + 4 * (size_t)row); return rsqrtf(((p[0] + p[1]) + (p[2] + p[3])) * (1.0f / DM) + RMS_EPS); }

namespace pg8 {
constexpr int BM = 256, BK = 64, HALF = 128, HTB = HALF * BK * 2, STAGE_BYTES = 8 * HTB, NXCD = 8, WGM = 8;
__host__ __device__ __forceinline__ int lds_byte(int r, int c) { return (r >> 3) * 1024 + (r & 7) * 128 + (((c >> 3) ^ ((r >> 1) & 7)) * 16) + (c & 7) * 2; }
__host__ __device__ __forceinline__ void stage_rc(int b, int& R, int& C) { const int st = b / 1024, ob = b % 1024; R = st * 8 + (ob >> 7); C = ((((ob >> 4) & 7) ^ ((R >> 1) & 7)) * 8); }
__host__ __device__ __forceinline__ int perm32(int rho) { const int n = rho >> 4, i = rho & 15; return 8 * (i >> 2) + 4 * n + (i & 3); }

struct Unit { int pm, pn; };
struct GemmP { int K, lda, ldb; };

struct TileOrder {
    int nM, nN, nwg, G, c;
    __device__ void init(int M, int N, int G_, int c_) { nM = M / BM; nN = N / BM; nwg = nM * nN; G = G_; c = c_; }
    __device__ bool tile(int i, Unit& u) const {
        const long L = (long)i * G + c; if (L >= nwg) return false;
        int wgid = (int)L; { const int q = nwg / NXCD, r = nwg % NXCD, xcd = wgid % NXCD, off = wgid / NXCD; wgid = (xcd < r ? xcd * (q + 1) : r * (q + 1) + (xcd - r) * q) + off; }
        const int nig = WGM * nN, gid = wgid / nig, fm = gid * WGM, gsz = (nM - fm) < WGM ? (nM - fm) : WGM;
        u.pm = fm + ((wgid % nig) % gsz); u.pn = (wgid % nig) / gsz; return true;
    }
};

template <class Epi, class Sched, bool ALIGN_EPI>
__device__ __forceinline__ void gemm_phase(LAS unsigned char* lds, const GemmP g, const Sched& S, const Epi& E) {
    int tid = threadIdx.x; asm volatile("" : "+v"(tid));
    const int wid = __builtin_amdgcn_readfirstlane(tid >> 6), lane = tid & 63, wr = wid >> 2, wc = wid & 3, fr = lane & 15, fq = lane >> 4;
    const int K = g.K, nt = K / BK;
    unsigned voffA[2], voffB[2];
#pragma unroll
    for (int i = 0; i < 2; ++i) { int R, C; stage_rc(tid * 16 + i * 8192, R, C); const int Rb = (R & ~31) + perm32(R & 31);
        voffA[i] = (unsigned)(R * g.lda + C) * 2u; voffB[i] = (unsigned)(Rb * g.ldb + C) * 2u; }
    const size_t kstep = (size_t)(BK * 2);
    const size_t hstepA = (size_t)HALF * g.lda * 2, hstepB = (size_t)HALF * g.ldb * 2;
    const unsigned ldsw = (unsigned)wid * 1024u;
    const int aoffk[2] = {lds_byte(wr * 64 + fr, fq * 8), lds_byte(wr * 64 + fr, 32 + fq * 8)}, boffk[2] = {lds_byte(wc * 32 + fr, fq * 8), lds_byte(wc * 32 + fr, 32 + fq * 8)};
#define PG8_SA(b, h) (((b) * 2 + (h)) * HTB)
#define PG8_SB(b, h) ((4 + (b) * 2 + (h)) * HTB)
#define PG8_STAGE(bufoff, gbase, voff) do { _Pragma("unroll") for (int _i = 0; _i < 2; ++_i) \
        __builtin_amdgcn_global_load_lds((const unsigned*)((const char*)(gbase) + (voff)[_i]), (LAS unsigned*)(lds + (bufoff) + ldsw + _i * 8192), 16, 0, 0); } while (0)
#define PG8_LDA(dst, b, h) do { _Pragma("unroll") for (int m = 0; m < 4; ++m) _Pragma("unroll") for (int k = 0; k < 2; ++k) dst[m][k] = *(const LAS bf16x8*)(lds + PG8_SA(b, h) + aoffk[k] + m * 2048); } while (0)
#define PG8_LDB(dst, b, h) do { _Pragma("unroll") for (int n = 0; n < 2; ++n) _Pragma("unroll") for (int k = 0; k < 2; ++k) dst[n][k] = *(const LAS bf16x8*)(lds + PG8_SB(b, h) + boffk[k] + n * 2048); } while (0)
#define PG8_MMA(ai, bj, At, Bt) do { __builtin_amdgcn_s_setprio(1); _Pragma("unroll") for (int m = 0; m < 4; ++m) _Pragma("unroll") for (int n = 0; n < 2; ++n) _Pragma("unroll") for (int k = 0; k < 2; ++k) \
        acc[ai][bj][m][n] = __builtin_amdgcn_mfma_f32_16x16x32_bf16(Bt[n][k], At[m][k], acc[ai][bj][m][n], 0, 0, 0); __builtin_amdgcn_s_setprio(0); } while (0)
#define PG8_WAIT_V(n) asm volatile("s_waitcnt vmcnt(" #n ")" ::: "memory")
#define PG8_WAIT_L(n) asm volatile("s_waitcnt lgkmcnt(" #n ")" ::: "memory")
#define PG8_BAR __builtin_amdgcn_s_barrier()
#define PG8_SCHED __builtin_amdgcn_sched_barrier(0)
    Unit cur, nxt; int ui = 0;
    if (!S.next(0, cur)) return;
    f32x4 acc[2][2][4][2];
#pragma unroll
    for (int a = 0; a < 2; ++a)
#pragma unroll
        for (int b = 0; b < 2; ++b)
#pragma unroll
            for (int m = 0; m < 4; ++m)
#pragma unroll
                for (int n = 0; n < 2; ++n) acc[a][b][m][n] = (f32x4){0.f, 0.f, 0.f, 0.f};
    bf16x8 At[4][2], B0[2][2], B1[2][2];
    const char* cA = S.opA(cur); const char* cB = S.opB(cur);
    PG8_STAGE(PG8_SB(0, 0), cB, voffB); PG8_STAGE(PG8_SB(0, 1), cB + hstepB, voffB); PG8_STAGE(PG8_SA(0, 0), cA, voffA); PG8_STAGE(PG8_SA(0, 1), cA + hstepA, voffA);
    if (wr == 1) PG8_BAR;
    PG8_WAIT_V(2); PG8_BAR;
    PG8_STAGE(PG8_SB(1, 0), cB + kstep, voffB); PG8_STAGE(PG8_SA(1, 0), cA + kstep, voffA); PG8_STAGE(PG8_SB(1, 1), cB + hstepB + kstep, voffB);
    PG8_WAIT_V(6); PG8_BAR;
    for (;;) {
        const bool has_next = S.next(ui + 1, nxt);
        const char* nA = has_next ? S.opA(nxt) : cA; const char* nB = has_next ? S.opB(nxt) : cB;
        for (int t = 0; t < nt; t += 2) {
            const bool last = (t == nt - 2);
            const char* a1 = cA + (size_t)(t + 1) * kstep;
            const char* a2 = last ? nA : cA + (size_t)(t + 2) * kstep; const char* b2 = last ? nB : cB + (size_t)(t + 2) * kstep;
            const char* a3 = a2 + kstep; const char* b3 = b2 + kstep;
            if constexpr (Epi::MID_T >= 0) { if (t == Epi::MID_T) E.mid(acc, cur, wr, wc, fr, fq); }
            PG8_LDB(B0, 0, 0); PG8_LDB(B1, 0, 1); PG8_SCHED; PG8_LDA(At, 0, 0); PG8_STAGE(PG8_SA(1, 1), a1 + hstepA, voffA);
            PG8_WAIT_V(8); PG8_WAIT_L(0); PG8_BAR; PG8_MMA(0, 0, At, B0); PG8_MMA(0, 1, At, B1); PG8_BAR; PG8_SCHED;
            PG8_LDA(At, 0, 1); PG8_STAGE(PG8_SB(0, 0), b2, voffB); PG8_STAGE(PG8_SB(0, 1), b2 + hstepB, voffB); PG8_STAGE(PG8_SA(0, 0), a2, voffA);
            PG8_WAIT_V(8); PG8_WAIT_L(0); PG8_BAR; PG8_MMA(1, 0, At, B0); PG8_MMA(1, 1, At, B1); PG8_BAR; PG8_SCHED;
            PG8_LDB(B0, 1, 0); PG8_LDB(B1, 1, 1); PG8_SCHED; PG8_LDA(At, 1, 0); PG8_STAGE(PG8_SA(0, 1), a2 + hstepA, voffA);
            PG8_WAIT_V(8); PG8_WAIT_L(0); PG8_BAR; PG8_MMA(0, 0, At, B0); PG8_MMA(0, 1, At, B1); PG8_BAR; PG8_SCHED;
            PG8_LDA(At, 1, 1); PG8_STAGE(PG8_SB(1, 0), b3, voffB); PG8_STAGE(PG8_SB(1, 1), b3 + hstepB, voffB); PG8_STAGE(PG8_SA(1, 0), a3, voffA);
            PG8_WAIT_V(8); PG8_WAIT_L(0); PG8_BAR; PG8_MMA(1, 0, At, B0); PG8_MMA(1, 1, At, B1); PG8_BAR; PG8_SCHED;
        }
        if constexpr (ALIGN_EPI) { if (wr == 0) PG8_BAR; }
        if constexpr (!Epi::AFTER_DRAIN) { E(acc, cur, wr, wc, fr, fq); }
        if (!has_next) break;
#pragma unroll
        for (int a = 0; a < 2; ++a)
#pragma unroll
            for (int b = 0; b < 2; ++b)
#pragma unroll
                for (int m = 0; m < 4; ++m)
#pragma unroll
                    for (int n = 0; n < 2; ++n) acc[a][b][m][n] = (f32x4){0.f, 0.f, 0.f, 0.f};
        cur = nxt; cA = nA; cB = nB; ++ui;
        if constexpr (ALIGN_EPI) { if (wr == 1) PG8_BAR; }
    }
    PG8_WAIT_V(0);
    if constexpr (!ALIGN_EPI) { if (wr == 0) PG8_BAR; }
    PG8_BAR;
    if constexpr (Epi::AFTER_DRAIN) { E.fused(acc, cur, wr, wc, fr, fq, lds, wid, lane); }
#undef PG8_SA
#undef PG8_SB
#undef PG8_STAGE
#undef PG8_LDA
#undef PG8_LDB
#undef PG8_MMA
#undef PG8_WAIT_V
#undef PG8_WAIT_L
#undef PG8_BAR
#undef PG8_SCHED
}
}
using pg8::Unit;
typedef f32x4 Acc[2][2][4][2];

struct SchedPlain {
    pg8::TileOrder T; const char* A; const char* Bt; size_t tA, tB;
    __device__ __forceinline__ bool next(int i, Unit& u) const { return T.tile(i, u); }
    __device__ __forceinline__ const char* opA(const Unit& u) const { return A + (size_t)(u.pm >> 3) * SLAB + (size_t)(u.pm & 7) * tA; }
    __device__ __forceinline__ const char* opB(const Unit& u) const { return Bt + (size_t)u.pn * tB; }
};
struct SchedWin {
    pg8::TileOrder T; const char* X; const char* W; size_t tX, tW;
    __device__ __forceinline__ bool next(int i, Unit& u) const { return T.tile(i, u); }
    __device__ __forceinline__ const char* xp(const Unit& u) const { return X + (size_t)(u.pm >> 3) * SLAB + (size_t)(u.pm & 7) * tX; }
    __device__ __forceinline__ const char* opA(const Unit& u) const { return (u.pn == 3 || u.pn == 4) ? W + (size_t)u.pn * tW : xp(u); }
    __device__ __forceinline__ const char* opB(const Unit& u) const { return (u.pn == 3 || u.pn == 4) ? xp(u) : W + (size_t)u.pn * tW; }
};
struct SchedOne {
    const char* A; const char* Bt; Unit u0;
    __device__ __forceinline__ bool next(int i, Unit& u) const { if (i > 0) return false; u = u0; return true; }
    __device__ __forceinline__ const char* opA(const Unit&) const { return A; }
    __device__ __forceinline__ const char* opB(const Unit&) const { return Bt; }
};

struct EpiSwiGLU {
    static constexpr bool AFTER_DRAIN = false; static constexpr int MID_T = -1;
    const float* RS; bf16_t* O;
    __device__ __forceinline__ void mid(Acc&, const Unit&, int, int, int, int) const {}
    __device__ __forceinline__ void operator()(const Acc& acc, const Unit& u, int wr, int wc, int fr, int fq) const {
        asm volatile("" : "+v"(fr), "+v"(fq));
        const int row0 = u.pm * 256 + wr * 64 + fr, col0 = u.pn * 128 + wc * 32 + 8 * fq;
        float rv[2][4];
#pragma unroll
        for (int ai = 0; ai < 2; ++ai)
#pragma unroll
            for (int m = 0; m < 4; ++m) rv[ai][m] = row_rinv(RS, row0 + ai * 128 + m * 16);
#pragma unroll
        for (int ai = 0; ai < 2; ++ai)
#pragma unroll
            for (int m = 0; m < 4; ++m) {
                const int row = row0 + ai * 128 + m * 16; const float r = rv[ai][m];
                f32x4 o[2];
#pragma unroll
                for (int n = 0; n < 2; ++n) { const f32x4 g = acc[ai][0][m][n] * r, up = acc[ai][1][m][n] * r;
#pragma unroll
                    for (int j = 0; j < 4; ++j) { const float e = __builtin_amdgcn_exp2f(-g[j] * LOG2E); o[n][j] = g[j] * up[j] * __builtin_amdgcn_rcpf(1.0f + e); } }
                st16(brow(O, row, DFF) + col0, pack8(o[0], o[1]));
            }
    }
};
template <bool XIN_F32> struct EpiResid {
    static constexpr bool AFTER_DRAIN = true; static constexpr int MID_T = -1;
    const float* xin; bf16_t* XB; float* RSo; float alpha;
    __device__ __forceinline__ void mid(Acc&, const Unit&, int, int, int, int) const {}
    __device__ __forceinline__ void operator()(const Acc&, const Unit&, int, int, int, int) const {}
    __device__ __forceinline__ void fused(Acc& acc, const Unit& u, int wr, int wc, int fr, int fq, LAS unsigned char* lds, int wid, int lane) const {
        asm volatile("" : "+v"(fr), "+v"(fq));
        LAS float* P = (LAS float*)lds;
#pragma unroll
        for (int ai = 0; ai < 2; ++ai) {
            u32x4 xr[4][2]; f32x4 xf[2][2][2];
            if constexpr (!XIN_F32) {
#pragma unroll
                for (int m = 0; m < 4; ++m)
#pragma unroll
                    for (int bj = 0; bj < 2; ++bj) xr[m][bj] = *(const u32x4*)(brow(XB, u.pm * 256 + ai * 128 + wr * 64 + m * 16 + fr, DM) + u.pn * 256 + bj * 128 + wc * 32 + 8 * fq);
            }
#pragma unroll
            for (int m = 0; m < 4; ++m) {
                const int rl = ai * 128 + wr * 64 + m * 16 + fr, row = u.pm * 256 + rl; float ss = 0.f;
                if constexpr (XIN_F32) { if ((m & 1) == 0) {
#pragma unroll
                    for (int mm = 0; mm < 2; ++mm)
#pragma unroll
                        for (int bj = 0; bj < 2; ++bj) { const size_t off = (size_t)(row + 16 * mm) * DM + u.pn * 256 + bj * 128 + wc * 32 + 8 * fq; xf[mm][bj][0] = *(const f32x4*)(xin + off); xf[mm][bj][1] = *(const f32x4*)(xin + off + 4); } } }
#pragma unroll
                for (int bj = 0; bj < 2; ++bj) {
                    const int col = u.pn * 256 + bj * 128 + wc * 32 + 8 * fq;
                    bf16_t* xb = brow(XB, row, DM) + col;
                    f32x4 x0, x1;
                    if constexpr (XIN_F32) { x0 = xf[m & 1][bj][0]; x1 = xf[m & 1][bj][1]; }
                    else unpack8(xr[m][bj], x0, x1);
                    x0 = x0 + acc[ai][bj][m][0] * alpha; x1 = x1 + acc[ai][bj][m][1] * alpha;
                    ss += (x0[0] * x0[0] + x0[1] * x0[1]) + (x0[2] * x0[2] + x0[3] * x0[3]) + (x1[0] * x1[0] + x1[1] * x1[1]) + (x1[2] * x1[2] + x1[3] * x1[3]);
                    st16(xb, pack8(x0, x1));
                }
                ss += __shfl_xor(ss, 16); ss += __shfl_xor(ss, 32);
                if (fq == 0) P[rl * 4 + wc] = ss;
            }
        }
        asm volatile("s_waitcnt lgkmcnt(0)" ::: "memory"); __builtin_amdgcn_s_barrier(); asm volatile("" ::: "memory");
        const int tid = wid * 64 + lane;
        if (tid < 256) { const f32x4 p = *(const LAS f32x4*)(P + tid * 4); RSo[(size_t)(u.pm * 256 + tid) * 4 + u.pn] = (p[0] + p[1]) + (p[2] + p[3]); }
    }
};
struct EpiWin {
    static constexpr bool AFTER_DRAIN = false; static constexpr int MID_T = -1;
    const float* RS; const float* bg; bf16_t* QKV; bf16_t* FT; bf16_t* GATES;
    __device__ __forceinline__ void mid(Acc&, const Unit&, int, int, int, int) const {}
    __device__ __forceinline__ void operator()(const Acc& acc, const Unit& u, int wr, int wc, int fr, int fq) const {
        asm volatile("" : "+v"(fr), "+v"(fq));
        if (u.pn < 3) {
            const int row0 = u.pm * 256 + wr * 64 + fr, col0 = u.pn * 256 + wc * 32 + 8 * fq;
            float rv[2][4];
#pragma unroll
            for (int ai = 0; ai < 2; ++ai)
#pragma unroll
                for (int m = 0; m < 4; ++m) rv[ai][m] = row_rinv(RS, row0 + ai * 128 + m * 16);
#pragma unroll
            for (int ai = 0; ai < 2; ++ai)
#pragma unroll
                for (int m = 0; m < 4; ++m) { const int row = row0 + ai * 128 + m * 16; const float r = rv[ai][m];
#pragma unroll
                    for (int bj = 0; bj < 2; ++bj) st16(brow(QKV, row, 768) + col0 + bj * 128, pack8(acc[ai][bj][m][0] * r, acc[ai][bj][m][1] * r)); }
        } else if (u.pn < 5) {
            f32x4 rt[2][2];
#pragma unroll
            for (int bj = 0; bj < 2; ++bj)
#pragma unroll
                for (int n = 0; n < 2; ++n)
#pragma unroll
                    for (int j = 0; j < 4; ++j) rt[bj][n][j] = row_rinv(RS, u.pm * 256 + bj * 128 + wc * 32 + 8 * fq + 4 * n + j);
            const int b = u.pm >> 3, s0 = (u.pm & 7) * 256 + wc * 32 + 8 * fq;
#pragma unroll
            for (int ai = 0; ai < 2; ++ai)
#pragma unroll
                for (int m = 0; m < 4; ++m) { const int ch = (u.pn - 3) * 256 + ai * 128 + wr * 64 + m * 16 + fr; bf16_t* base = FT + (size_t)b * SLAB_E + (size_t)ch * SEQ + s0;
#pragma unroll
                    for (int bj = 0; bj < 2; ++bj) st16(base + bj * 128, pack8(acc[ai][bj][m][0] * rt[bj][0], acc[ai][bj][m][1] * rt[bj][1])); }
        } else {
            const int c0 = (u.pn - 5) * 128 + wc * 32 + 8 * fq, row0 = u.pm * 256 + wr * 64 + fr;
            f32x4 ba[2], bb[2];
#pragma unroll
            for (int n = 0; n < 2; ++n) { ba[n] = *(const f32x4*)(bg + c0 + 4 * n); bb[n] = *(const f32x4*)(bg + DM + c0 + 4 * n); }
            float rv[2][4];
#pragma unroll
            for (int ai = 0; ai < 2; ++ai)
#pragma unroll
                for (int m = 0; m < 4; ++m) rv[ai][m] = row_rinv(RS, row0 + ai * 128 + m * 16);
#pragma unroll
            for (int ai = 0; ai < 2; ++ai)
#pragma unroll
                for (int m = 0; m < 4; ++m) { const int row = row0 + ai * 128 + m * 16; const float r = rv[ai][m];
                    f32x4 ra[2], gb[2];
#pragma unroll
                    for (int n = 0; n < 2; ++n) { const f32x4 za = acc[ai][0][m][n] * r + ba[n], zb = acc[ai][1][m][n] * r + bb[n];
#pragma unroll
                        for (int j = 0; j < 4; ++j) { const float ea = __builtin_amdgcn_exp2f(-za[j] * LOG2E), eb = __builtin_amdgcn_exp2f(-zb[j] * LOG2E);
                            ra[n][j] = (1.0f + eb) * __builtin_amdgcn_rcpf(1.0f + ea); gb[n][j] = __builtin_amdgcn_rcpf(1.0f + eb); } }
                    bf16_t* gp = brow(GATES, row, 2048) + c0; st16(gp, pack8(ra[0], ra[1])); st16(gp + DM, pack8(gb[0], gb[1])); }
        }
    }
};
struct EpiDft {
    static constexpr bool AFTER_DRAIN = false; static constexpr int MID_T = -1;
    bf16_t* AOPQ; int b;
    __device__ __forceinline__ void mid(Acc&, const Unit&, int, int, int, int) const {}
    __device__ __forceinline__ void operator()(const Acc& acc, const Unit& u, int wr, int wc, int fr, int fq) const {
        asm volatile("" : "+v"(fr), "+v"(fq));
        const int part = u.pm >> 2, k0 = (u.pm & 3) * 256 + wr * 64 + fr;
        bf16_t* ab = AOPQ + (size_t)b * SLAB_E + 512 + wc * 32 + 8 * fq;
#pragma unroll
        for (int ai = 0; ai < 2; ++ai)
#pragma unroll
            for (int m = 0; m < 4; ++m) { const int k = k0 + ai * 128 + m * 16;
#pragma unroll
                for (int bj = 0; bj < 2; ++bj) { const int cg = (u.pn * 2 + bj) * 256; const f32x4 v0 = acc[ai][bj][m][0], v1 = acc[ai][bj][m][1];
                    if (part == 0) { const u32x4 w = pack8(v0, v1); st16(ab + (size_t)k * KAB + cg, w); if (k != 0) st16(ab + (size_t)(SEQ - k) * KAB + cg, w); }
                    else if (k != 0) { st16(ab + (size_t)k * KAB + cg + 128, pack8(v0, v1)); st16(ab + (size_t)(SEQ - k) * KAB + cg + 128, pack8(-v0, -v1)); }
                    else { const u32x4 z = (u32x4){0u, 0u, 0u, 0u}; st16(ab + (size_t)1024 * KAB + cg, pack8(v0, v1)); st16(ab + cg + 128, z); st16(ab + (size_t)1024 * KAB + cg + 128, z); } } }
    }
};
struct EpiGate {
    static constexpr bool AFTER_DRAIN = false; static constexpr int MID_T = 8;
    bf16_t* GATES;
    __device__ __forceinline__ void scale(Acc& acc, const Unit& u, int wr, int wc, int fr, int fq, int goff) const {
        asm volatile("" : "+v"(fr), "+v"(fq));
        u32x4 w[2][4][2];
#pragma unroll
        for (int ai = 0; ai < 2; ++ai)
#pragma unroll
            for (int m = 0; m < 4; ++m)
#pragma unroll
                for (int bj = 0; bj < 2; ++bj) w[ai][m][bj] = *(const u32x4*)(brow(GATES, u.pm * 256 + ai * 128 + wr * 64 + m * 16 + fr, 2048) + goff + u.pn * 256 + bj * 128 + wc * 32 + 8 * fq);
#pragma unroll
        for (int ai = 0; ai < 2; ++ai)
#pragma unroll
            for (int m = 0; m < 4; ++m)
#pragma unroll
                for (int bj = 0; bj < 2; ++bj) { f32x4 s0, s1; unpack8(w[ai][m][bj], s0, s1);
                    acc[ai][bj][m][0] = acc[ai][bj][m][0] * s0; acc[ai][bj][m][1] = acc[ai][bj][m][1] * s1; }
    }
    __device__ __forceinline__ void mid(Acc& acc, const Unit& u, int wr, int wc, int fr, int fq) const { scale(acc, u, wr, wc, fr, fq, 0); }
    __device__ __forceinline__ void operator()(Acc& acc, const Unit& u, int wr, int wc, int fr, int fq) const {
        scale(acc, u, wr, wc, fr, fq, DM);
#pragma unroll
        for (int ai = 0; ai < 2; ++ai)
#pragma unroll
            for (int m = 0; m < 4; ++m) { const int row = u.pm * 256 + ai * 128 + wr * 64 + m * 16 + fr;
#pragma unroll
                for (int bj = 0; bj < 2; ++bj) st16(brow(GATES, row, 2048) + u.pn * 256 + bj * 128 + wc * 32 + 8 * fq, pack8(acc[ai][bj][m][0], acc[ai][bj][m][1])); }
    }
};

namespace att {
constexpr int LDS_K = 0, LDS_V = 49152, LDS_OST = 98304;
__device__ __forceinline__ int crow(int r, int hi) { return (r & 3) + 8 * (r >> 2) + 4 * hi; }
__device__ __forceinline__ int t5_bucket(int rel) {
    const int n = rel < 0 ? -rel : rel; int b;
    if (n < 8) b = n; else if (n < 12) b = 8; else if (n < 16) b = 9; else if (n < 23) b = 10; else if (n < 32) b = 11; else if (n < 46) b = 12; else if (n < 64) b = 13; else if (n < 91) b = 14; else b = 15;
    return b + (rel > 0 ? 16 : 0);
}
__device__ __forceinline__ s16x4 vtr(const LAS unsigned char* p) { typedef short v4i16_t __attribute__((ext_vector_type(4))); return __builtin_bit_cast(s16x4, __builtin_amdgcn_ds_read_tr16_b64_v4i16((LAS v4i16_t*)p)); }
__device__ __forceinline__ unsigned short f2bf(float f) { unsigned u = __builtin_bit_cast(unsigned, f); return (unsigned short)((u + 0x7fffu + ((u >> 16) & 1u)) >> 16); }

__device__ __forceinline__ void attn_unit(LAS unsigned char* ring, LAS float* biasT  , LAS float* wsfAll  , const bf16_t* QKV, bf16_t* AOPQ,
                                          const float* sink, const float* relb, int b, int kvh, int n) {
    const int tid = threadIdx.x, lane = tid & 63, r32 = lane & 31, hi = lane >> 5, wid = __builtin_amdgcn_readfirstlane(tid >> 6);
    for (int t = tid; t < 4 * 512; t += 512) { const int g = t >> 9, rel = (t & 511) - 256; biasT[t] = (rel >= -128 && rel <= 128) ? relb[t5_bucket(rel) * 8 + kvh * 4 + g] * LOG2E : -INFINITY; }
    const int tlo = (n == 0) ? 2 : 0, thi = (n == 15) ? 3 : 5;
    const size_t rowb = 0; QKV += (size_t)b * SLAB_E; AOPQ += (size_t)b * SLAB_E; const int key0 = 128 * (n - 1);
    for (int t = tlo; t <= thi; ++t) {
        const bf16_t* ks = QKV + (rowb + key0 + 64 * t + lane) * 768 + 512 + kvh * 64 + wid * 8;
        __builtin_amdgcn_global_load_lds((const unsigned*)ks, (LAS unsigned*)(ring + LDS_K + t * 8192 + wid * 1024), 16, 0, 0);
        const bf16_t* vs = QKV + (rowb + key0 + 64 * t + 16 * (wid & 3) + (lane >> 2)) * 768 + 640 + kvh * 64 + (wid >> 2) * 32 + (lane & 3) * 8;
        __builtin_amdgcn_global_load_lds((const unsigned*)vs, (LAS unsigned*)(ring + LDS_V + t * 8192 + wid * 1024), 16, 0, 0);
    }
    asm volatile("s_waitcnt vmcnt(0) lgkmcnt(0)" ::: "memory"); __builtin_amdgcn_s_barrier(); asm volatile("" ::: "memory");
    const int g = wid >> 1, h = kvh * 4 + g;
    LAS float* wsf = wsfAll + wid * 128; const LAS float* bT = biasT + g * 512;
    const float sinkl = sink[h] * LOG2E;
    const int q0b = (wid & 1) * 64;
    bf16x8 qr[2][4]; float m_run[2], l_run[2]; f32x16 o0[2], o1[2];
#pragma unroll
    for (int qq = 0; qq < 2; ++qq) {
        const bf16_t* qp = QKV + (rowb + 128 * n + q0b + 32 * qq + r32) * 768 + h * 64 + hi * 8;
#pragma unroll
        for (int d0 = 0; d0 < 4; ++d0) qr[qq][d0] = *(const bf16x8*)(qp + d0 * 16);
        m_run[qq] = sinkl; l_run[qq] = hi ? 0.f : 1.f;
#pragma unroll
        for (int r = 0; r < 16; ++r) { o0[qq][r] = 0.f; o1[qq][r] = 0.f; }
    }
    int t0 = q0b >> 6, t1 = (287 + q0b) >> 6; t0 = t0 < tlo ? tlo : t0; t1 = t1 > thi ? thi : t1;
    for (int t = t0; t <= t1; ++t) {
        f32x16 p0[2], p1[2];
#pragma unroll
        for (int qq = 0; qq < 2; ++qq)
#pragma unroll
            for (int r = 0; r < 16; ++r) { p0[qq][r] = 0.f; p1[qq][r] = 0.f; }
        const LAS unsigned char* kb = ring + LDS_K + t * 8192 + hi * 1024 + r32 * 16;
#pragma unroll
        for (int d0 = 0; d0 < 4; ++d0) { const bf16x8 k0 = *(const LAS bf16x8*)(kb + d0 * 2048), k1 = *(const LAS bf16x8*)(kb + d0 * 2048 + 512);
#pragma unroll
            for (int qq = 0; qq < 2; ++qq) { p0[qq] = __builtin_amdgcn_mfma_f32_32x32x16_bf16(k0, qr[qq][d0], p0[qq], 0, 0, 0); p1[qq] = __builtin_amdgcn_mfma_f32_32x32x16_bf16(k1, qr[qq][d0], p1[qq], 0, 0, 0); } }
        u32x4 pw[2][4];
#pragma unroll
        for (int qq = 0; qq < 2; ++qq) {
            const int qpos = 128 + q0b + 32 * qq + r32;
            const LAS float* bp = bT + (64 * t - qpos + 256 + 4 * hi);
            float tm = -INFINITY;
#pragma unroll
            for (int r = 0; r < 16; ++r) { const int o = (r & 3) + 8 * (r >> 2);
                p0[qq][r] += bp[o]; p1[qq][r] += bp[o + 32];
                tm = fmaxf(tm, fmaxf(p0[qq][r], p1[qq][r])); }
            tm = fmaxf(tm, __shfl_xor(tm, 32));
            const float mn = fmaxf(m_run[qq], tm), alpha = __builtin_amdgcn_exp2f(m_run[qq] - mn); m_run[qq] = mn;
            float rs = 0.f;
#pragma unroll
            for (int r = 0; r < 16; ++r) { p0[qq][r] = __builtin_amdgcn_exp2f(p0[qq][r] - mn); p1[qq][r] = __builtin_amdgcn_exp2f(p1[qq][r] - mn); rs += p0[qq][r] + p1[qq][r]; }
            l_run[qq] = l_run[qq] * alpha + rs;
            if (__any(alpha != 1.0f)) {
                if (hi == 0) wsf[32 * qq + r32] = alpha;
                asm volatile("s_waitcnt lgkmcnt(0)" ::: "memory");
#pragma unroll
                for (int r = 0; r < 16; ++r) { const float a = wsf[32 * qq + crow(r, hi)]; o0[qq][r] *= a; o1[qq][r] *= a; }
            }
            pw[qq][0] = (u32x4){cvtpk(p0[qq][0], p0[qq][1]), cvtpk(p0[qq][2], p0[qq][3]), cvtpk(p0[qq][4], p0[qq][5]), cvtpk(p0[qq][6], p0[qq][7])};
            pw[qq][1] = (u32x4){cvtpk(p0[qq][8], p0[qq][9]), cvtpk(p0[qq][10], p0[qq][11]), cvtpk(p0[qq][12], p0[qq][13]), cvtpk(p0[qq][14], p0[qq][15])};
            pw[qq][2] = (u32x4){cvtpk(p1[qq][0], p1[qq][1]), cvtpk(p1[qq][2], p1[qq][3]), cvtpk(p1[qq][4], p1[qq][5]), cvtpk(p1[qq][6], p1[qq][7])};
            pw[qq][3] = (u32x4){cvtpk(p1[qq][8], p1[qq][9]), cvtpk(p1[qq][10], p1[qq][11]), cvtpk(p1[qq][12], p1[qq][13]), cvtpk(p1[qq][14], p1[qq][15])};
        }
        const LAS unsigned char* vb = ring + LDS_V + t * 8192 + ((lane >> 4) & 1) * 32 + (lane & 3) * 8 + (4 * hi + ((lane & 15) >> 2)) * 64;
#pragma unroll
        for (int ks = 0; ks < 4; ++ks) {
            const s16x4 l0 = vtr(vb + ks * 1024), h0 = vtr(vb + ks * 1024 + 512), l1 = vtr(vb + 4096 + ks * 1024), h1 = vtr(vb + 4096 + ks * 1024 + 512);
            const bf16x8 v0 = (bf16x8){l0[0], l0[1], l0[2], l0[3], h0[0], h0[1], h0[2], h0[3]}, v1 = (bf16x8){l1[0], l1[1], l1[2], l1[3], h1[0], h1[1], h1[2], h1[3]};
#pragma unroll
            for (int qq = 0; qq < 2; ++qq) { const bf16x8 pa = __builtin_bit_cast(bf16x8, pw[qq][ks]);
                o0[qq] = __builtin_amdgcn_mfma_f32_32x32x16_bf16(pa, v0, o0[qq], 0, 0, 0); o1[qq] = __builtin_amdgcn_mfma_f32_32x32x16_bf16(pa, v1, o1[qq], 0, 0, 0); }
        }
    }
#pragma unroll
    for (int qq = 0; qq < 2; ++qq) {
        const int q0 = q0b + 32 * qq;
        const float lt = l_run[qq] + __shfl_xor(l_run[qq], 32);
        if (hi == 0) wsf[64 + 32 * qq + r32] = lt;
        asm volatile("s_waitcnt lgkmcnt(0)" ::: "memory");
        LAS unsigned short* stg = (LAS unsigned short*)(ring + LDS_OST + wid * 4096);
#pragma unroll
        for (int r = 0; r < 16; ++r) { const int orow = crow(r, hi); const float rli = __builtin_amdgcn_rcpf(wsf[64 + 32 * qq + orow]);
            stg[orow * 64 + r32] = f2bf(o0[qq][r] * rli); stg[orow * 64 + 32 + r32] = f2bf(o1[qq][r] * rli); }
        asm volatile("s_waitcnt lgkmcnt(0)" ::: "memory");
#pragma unroll
        for (int i = 0; i < 4; ++i) { const int row = i * 8 + (lane >> 3), ch = lane & 7; const u32x4 v = *(const LAS u32x4*)(stg + row * 64 + ch * 8);
            st16(AOPQ + (rowb + 128 * n + q0 + row) * KAB + h * 64 + ch * 8, v); }
        asm volatile("s_waitcnt lgkmcnt(0)" ::: "memory");
    }
}
}

constexpr size_t MiB = 1u << 20;
constexpr size_t WS_CTL = 0, CTL_ZERO_BYTES = 64 * 1024;
constexpr size_t WS_RS = 256 * 1024;
constexpr size_t RS_BYTES = (size_t)MTOK * 4 * 4;
constexpr size_t WS_WUP1 = 2 * MiB;
constexpr size_t WS_WDN1 = WS_WUP1 + 11 * MiB;
constexpr size_t WS_WIN = WS_WDN1 + 11 * MiB / 2;
constexpr size_t WS_WAB = WS_WIN + 13 * MiB / 2;
constexpr size_t WS_WO = WS_WAB + 3 * MiB;
constexpr size_t WS_WUP2 = WS_WO + 2 * MiB;
constexpr size_t WS_WDN2 = WS_WUP2 + 11 * MiB;
constexpr size_t WS_TM = WS_WDN2 + 11 * MiB / 2;
constexpr size_t WS_SLAB0 = WS_TM + 16 * MiB;
constexpr size_t WS_XB = WS_SLAB0, WS_AFF = WS_SLAB0 + 4 * MiB, WS_QKV = WS_SLAB0 + 4 * MiB, WS_FT = WS_SLAB0 + 7 * MiB, WS_GATES = WS_SLAB0 + 9 * MiB, WS_AOPQ = WS_SLAB0 + 17 * MiB;
constexpr size_t WS_END = WS_SLAB0 + 8 * SLAB;
static_assert(WS_END <= 256 * MiB && WS_RS + 4 * RS_BYTES <= WS_WUP1, "d_ws map");
static_assert((size_t)SEQ * DM * 2 == 4 * MiB && (size_t)SEQ * DFF * 2 == 11 * MiB && (size_t)SEQ * 768 * 2 == 3 * MiB && (size_t)512 * SEQ * 2 == 2 * MiB && (size_t)SEQ * 2048 * 2 == 8 * MiB && (size_t)SEQ * KAB * 2 == 6 * MiB, "slab pieces");

constexpr int RING_BYTES = 131072, LDSCTL_OFF = RING_BYTES, MISC_OFF = LDSCTL_OFF + 320, BIAS_OFF = LDSCTL_OFF + 512, WSF_OFF = BIAS_OFF + 4 * 512 * 4, LDS_BYTES = 147456;
static_assert(WSF_OFF + 8 * 128 * 4 <= LDS_BYTES, "LDS map");

#define XB_TMO      128
#define XB_XCNT(j)  (256  + 64 * (j))
#define XB_XSUB(j)  (1280 + 64 * (j))
#define XB_XGEN(j)  (2304 + 64 * (j))
#define XB_TOP      3328
#define XB_TOPGEN   3392
#define XCD_BAR_WORDS 3456
#define XB_SPIN_CAP (1u << 18)
__device__ __forceinline__ unsigned xb_ld(unsigned* p)              { return __hip_atomic_load(p, __ATOMIC_RELAXED, __HIP_MEMORY_SCOPE_AGENT); }
__device__ __forceinline__ unsigned xb_add(unsigned* p, unsigned v) { return __hip_atomic_fetch_add(p, v, __ATOMIC_RELAXED, __HIP_MEMORY_SCOPE_AGENT); }
__device__ __forceinline__ unsigned xb_xcc_id() { return (unsigned)__builtin_amdgcn_s_getreg((3 << 11) | 20) & 0xFu; }
#define XB_SPIN(cond, bar) do { unsigned _sp = 0; while (cond) { __builtin_amdgcn_s_sleep(1); \
    if ((++_sp & 255u) == 0u) { if (xb_ld(&(bar)[XB_TMO])) break; if (_sp > XB_SPIN_CAP) { atomicAdd(&(bar)[XB_TMO], 1u); break; } } } } while (0)
struct XcdBarrier { unsigned* bar; unsigned x; volatile LAS unsigned* st; };
__device__ __forceinline__ XcdBarrier xcd_barrier_post(unsigned* bar, volatile LAS unsigned* st) {
    XcdBarrier b; b.bar = bar; b.x = xb_xcc_id(); b.st = st;
    if (threadIdx.x == 0) (void)xb_add(&bar[XB_XCNT(b.x)], 1u);
    return b;
}
__device__ __forceinline__ void xcd_barrier_complete(unsigned* bar, unsigned x, unsigned& nloc, unsigned& nx) {
    const unsigned G = gridDim.x * gridDim.y * gridDim.z;
    unsigned sum, cnt, mine, sp = 0u;
    for (;;) {
        sum = 0u; cnt = 0u; mine = 0u;
#pragma unroll
        for (unsigned j = 0; j < 16; ++j) { const unsigned c = xb_ld(&bar[XB_XCNT(j)]); sum += c; cnt += (c > 0u) ? 1u : 0u; mine = (j == x) ? c : mine; }
        if (sum == G) break;
        __builtin_amdgcn_s_sleep(1);
        if ((++sp & 255u) == 0u) { if (xb_ld(&bar[XB_TMO])) break; if (sp > XB_SPIN_CAP) { atomicAdd(&bar[XB_TMO], 1u); break; } }
    }
    nloc = mine > 0u ? mine : 1u; nx = cnt > 0u ? cnt : 1u;
}
__device__ __forceinline__ void xcd_barrier(const XcdBarrier& b) {
    asm volatile("s_waitcnt vmcnt(0)" ::: "memory");
    __syncthreads();
    if (threadIdx.x == 0) {
        unsigned* bar = b.bar;
        __builtin_amdgcn_s_waitcnt(0);
        unsigned nloc = b.st[0], nx = b.st[1];
        if (nloc == 0u) { xcd_barrier_complete(bar, b.x, nloc, nx); b.st[0] = nloc; b.st[1] = nx; }
        const unsigned old = xb_add(&bar[XB_XSUB(b.x)], 1u);
        const unsigned gen = old / nloc;
        if (old + 1u == (gen + 1u) * nloc) {
            __builtin_amdgcn_fence(__ATOMIC_RELEASE, "agent");
            asm volatile("s_waitcnt vmcnt(0)" ::: "memory");
            const unsigned og = xb_add(&bar[XB_TOP], 1u);
            const unsigned tg = og / nx;
            if (og + 1u == (tg + 1u) * nx) xb_add(&bar[XB_TOPGEN], 1u);
            else XB_SPIN(xb_ld(&bar[XB_TOPGEN]) == tg, bar);
            __builtin_amdgcn_fence(__ATOMIC_ACQUIRE, "agent");
            xb_add(&bar[XB_XGEN(b.x)], 1u);
            asm volatile("s_waitcnt vmcnt(0)" ::: "memory");
        } else {
            XB_SPIN(xb_ld(&bar[XB_XGEN(b.x)]) == gen, bar);
            __builtin_amdgcn_fence(__ATOMIC_ACQUIRE, "agent");
            asm volatile("s_waitcnt vmcnt(0)" ::: "memory");
        }
    }
    __syncthreads();
}


__device__ __forceinline__ void group_barrier(unsigned* cnt, unsigned target, bool pure, unsigned* tmo) {
    asm volatile("s_waitcnt vmcnt(0)" ::: "memory");
    __syncthreads();
    if (threadIdx.x == 0) {
        if (!pure) { __builtin_amdgcn_fence(__ATOMIC_RELEASE, "agent"); asm volatile("s_waitcnt vmcnt(0)" ::: "memory"); }
        (void)xb_add(cnt, 1u);
        unsigned sp = 0u;
        while (xb_ld(cnt) < target) { __builtin_amdgcn_s_sleep(1); if ((++sp & 255u) == 0u) { if (xb_ld(tmo)) break; if (sp > XB_SPIN_CAP) { atomicAdd(tmo, 1u); break; } } }
        __builtin_amdgcn_fence(__ATOMIC_ACQUIRE, "agent");
        asm volatile("s_waitcnt vmcnt(0)" ::: "memory");
    }
    __syncthreads();
}


struct EpiFinal {
    static constexpr bool AFTER_DRAIN = true; static constexpr int MID_T = -1;
    const bf16_t* XB; float* out; float* RSo; const float* gfin; float alpha; unsigned* cnt; unsigned target; bool pure; unsigned* tmo;
    __device__ __forceinline__ void mid(Acc&, const Unit&, int, int, int, int) const {}
    __device__ __forceinline__ void operator()(const Acc&, const Unit&, int, int, int, int) const {}
    __device__ __forceinline__ void fused(Acc& acc, const Unit& u, int wr, int wc, int fr, int fq, LAS unsigned char* lds, int wid, int lane) const {
        asm volatile("" : "+v"(fr), "+v"(fq));
        LAS float* P = (LAS float*)lds;
#pragma unroll
        for (int ai = 0; ai < 2; ++ai) {
            u32x4 xr[4][2];
#pragma unroll
            for (int m = 0; m < 4; ++m)
#pragma unroll
                for (int bj = 0; bj < 2; ++bj) xr[m][bj] = *(const u32x4*)(brow(XB, u.pm * 256 + ai * 128 + wr * 64 + m * 16 + fr, DM) + u.pn * 256 + bj * 128 + wc * 32 + 8 * fq);
#pragma unroll
            for (int m = 0; m < 4; ++m) {
                const int rl = ai * 128 + wr * 64 + m * 16 + fr, row = u.pm * 256 + rl; float ss = 0.f;
#pragma unroll
                for (int bj = 0; bj < 2; ++bj) {
                    f32x4 x0, x1; unpack8(xr[m][bj], x0, x1);
                    x0 = x0 + acc[ai][bj][m][0] * alpha; x1 = x1 + acc[ai][bj][m][1] * alpha;
                    acc[ai][bj][m][0] = x0; acc[ai][bj][m][1] = x1;
                    ss += (x0[0] * x0[0] + x0[1] * x0[1]) + (x0[2] * x0[2] + x0[3] * x0[3]) + (x1[0] * x1[0] + x1[1] * x1[1]) + (x1[2] * x1[2] + x1[3] * x1[3]);
                }
                ss += __shfl_xor(ss, 16); ss += __shfl_xor(ss, 32);
                if (fq == 0) P[rl * 4 + wc] = ss;
            }
        }
        asm volatile("s_waitcnt lgkmcnt(0)" ::: "memory"); __builtin_amdgcn_s_barrier(); asm volatile("" ::: "memory");
        const int tid = wid * 64 + lane;
        if (tid < 256) { const f32x4 p = *(const LAS f32x4*)(P + tid * 4); RSo[(size_t)(u.pm * 256 + tid) * 4 + u.pn] = (p[0] + p[1]) + (p[2] + p[3]); }
        group_barrier(cnt, target, pure, tmo);
        asm volatile("" : "+v"(fr), "+v"(fq));
        f32x4 gv[2][2];
#pragma unroll
        for (int bj = 0; bj < 2; ++bj)
#pragma unroll
            for (int n = 0; n < 2; ++n) gv[bj][n] = *(const f32x4*)(gfin + u.pn * 256 + bj * 128 + wc * 32 + 8 * fq + 4 * n);
        float rv[2][4];
#pragma unroll
        for (int ai = 0; ai < 2; ++ai)
#pragma unroll
            for (int m = 0; m < 4; ++m) rv[ai][m] = row_rinv(RSo, u.pm * 256 + ai * 128 + wr * 64 + m * 16 + fr);
#pragma unroll
        for (int ai = 0; ai < 2; ++ai)
#pragma unroll
            for (int m = 0; m < 4; ++m) {
                const int row = u.pm * 256 + ai * 128 + wr * 64 + m * 16 + fr; const float r = rv[ai][m];
#pragma unroll
                for (int bj = 0; bj < 2; ++bj) { const size_t off = (size_t)row * DM + u.pn * 256 + bj * 128 + wc * 32 + 8 * fq;
                    st16f(out + off, acc[ai][bj][m][0] * gv[bj][0] * r); st16f(out + off + 4, acc[ai][bj][m][1] * gv[bj][1] * r); }
            }
    }
};

__device__ __forceinline__ float wave_sum(float v) {
#pragma unroll
    for (int o = 1; o < 64; o <<= 1) v += __shfl_xor(v, o);
    return v;
}
__device__ __forceinline__ int map_up(int rho) { const int pn = rho >> 8, i = rho & 255; return i < 128 ? 128 * pn + i : DFF + 128 * pn + (i - 128); }
__device__ __forceinline__ int map_in(int rho) { if (rho < 1280) return rho; const int t = (rho - 1280) >> 8, i = (rho - 1280) & 255; return i < 128 ? 1280 + 128 * t + i : 2304 + 128 * t + (i - 128); }

struct Args { const float* in[16]; float* out; unsigned char* ws; };

__global__ void __launch_bounds__(512, 2) mega_fwd(Args args) {
    extern __shared__ __attribute__((aligned(16))) unsigned char lds_raw[];
    LAS unsigned char* lds = (LAS unsigned char*)lds_raw;
    volatile LAS unsigned* MISC = (volatile LAS unsigned*)(lds + MISC_OFF);
    const int tid = threadIdx.x, lane = tid & 63, wave = __builtin_amdgcn_readfirstlane(tid >> 6);
    const int G = gridDim.x, bx = blockIdx.x;
    const int vcu = (G % 8 == 0) ? (bx % 8) * (G / 8) + bx / 8 : bx;
    unsigned char* ws = args.ws;
    unsigned* ctl = (unsigned*)(ws + WS_CTL);
    const float* x = args.in[0]; const float* g_ffn1 = args.in[1]; const float* w_up1 = args.in[2]; const float* w_dn1 = args.in[3]; const float* g_mix = args.in[4]; const float* w_in = args.in[5];
    const float* b_gate = args.in[6]; const float* sink = args.in[7]; const float* rel_bias = args.in[8]; const float* w_a = args.in[9]; const float* w_b = args.in[10]; const float* w_o = args.in[11];
    const float* g_ffn2 = args.in[12]; const float* w_up2 = args.in[13]; const float* w_dn2 = args.in[14]; const float* g_final = args.in[15];
    float* out = args.out;
    bf16_t* Wup1 = (bf16_t*)(ws + WS_WUP1); bf16_t* Wdn1 = (bf16_t*)(ws + WS_WDN1); bf16_t* Win = (bf16_t*)(ws + WS_WIN); bf16_t* Wab = (bf16_t*)(ws + WS_WAB); bf16_t* Wo = (bf16_t*)(ws + WS_WO);
    bf16_t* Wup2 = (bf16_t*)(ws + WS_WUP2); bf16_t* Wdn2 = (bf16_t*)(ws + WS_WDN2); bf16_t* Tm = (bf16_t*)(ws + WS_TM); bf16_t* XB = (bf16_t*)(ws + WS_XB);
    bf16_t* AFF = (bf16_t*)(ws + WS_AFF); bf16_t* QKV = (bf16_t*)(ws + WS_QKV); bf16_t* FT = (bf16_t*)(ws + WS_FT); bf16_t* GATES = (bf16_t*)(ws + WS_GATES); bf16_t* AOPQ = (bf16_t*)(ws + WS_AOPQ);
    float* RS0 = (float*)(ws + WS_RS); float* RS1 = (float*)(ws + WS_RS + RS_BYTES); float* RS2 = (float*)(ws + WS_RS + 2 * RS_BYTES); float* RS3 = (float*)(ws + WS_RS + 3 * RS_BYTES);

    for (int u = tid; u < (LDS_BYTES - LDSCTL_OFF) / 4; u += 512) ((LAS unsigned*)(lds + LDSCTL_OFF))[u] = 0u;
    __syncthreads();
    if (PROBE_K >= 0 && bx == 0 && tid == 0) { const unsigned long long t_ = __builtin_amdgcn_s_memrealtime(); MISC[18] = (unsigned)t_; MISC[19] = (unsigned)(t_ >> 32); }
    XcdBarrier bar = xcd_barrier_post(ctl + 1024, MISC + 8);
    unsigned* grp_cnt = ctl + 8192 + 64 * (bx & 7); unsigned* grp_census = ctl + 6144 + 16 * (bx & 7); unsigned grp_gen = 0u; bool grp_pure = false;
    if (tid == 0) (void)xb_add(grp_census + (bar.x & 15u), 1u);
#define GRID_BAR() xcd_barrier(bar)
#define STAMP(k) do { if ((k) == PROBE_K && bx == 0 && tid == 0) { const unsigned long long t_ = __builtin_amdgcn_s_memrealtime(); MISC[16] = (unsigned)t_; MISC[17] = (unsigned)(t_ >> 32); } } while (0)
#define GROUP_BAR() do { ++grp_gen; group_barrier(grp_cnt, grp_gen * (unsigned)(G / 8), grp_pure, ctl + 1024 + XB_TMO); } while (0)
#ifndef REPEAT
#define REPEAT -1
#endif
#ifndef NREP
#define NREP 2
#endif
#define PH(n) for (int rep_ = 0; rep_ < ((n) == REPEAT ? NREP : 1); ++rep_)

    constexpr int I_UP = 16 * (NUP / 32), I_DN = (DFF / 64) * (DM / 32), I_IN = 16 * (INW / 32), I_A = 8 * 32, I_O = 16 * 32;
    constexpr int NITEMS = 2 * I_UP + 2 * I_DN + I_IN + I_A + I_O;
    LAS float* cosT = (LAS float*)(lds + 8 * 8448);
    auto p0_transposes = [&](const int IT0, const int IT1, const int GW_, const int NGW_) {
        {
            LAS float* scr = (LAS float*)(lds + wave * 8448);
            const int kr = lane >> 3, c4 = lane & 7;
            struct TI { const float* src; const float* gk; bf16_t* dst; int ldsrc, ldd, k0; float cs; };
            auto decode = [&](int it, TI& t) {
                int r = it;
                if (r < 2 * I_UP) { const int second = r >= I_UP; if (second) r -= I_UP; const int nb = r % (NUP / 32), kb = r / (NUP / 32);
                    t.src = (second ? w_up2 : w_up1) + map_up(32 * nb); t.ldsrc = NUP; t.gk = second ? g_ffn2 : g_ffn1; t.cs = 1.0f; t.dst = (second ? Wup2 : Wup1) + (size_t)(32 * nb) * DM; t.ldd = DM; t.k0 = 64 * kb; return; }
                r -= 2 * I_UP;
                if (r < 2 * I_DN) { const int second = r >= I_DN; if (second) r -= I_DN; const int nb = r % 32, kb = r / 32;
                    t.src = (second ? w_dn2 : w_dn1) + 32 * nb; t.ldsrc = DM; t.gk = nullptr; t.cs = 1.0f; t.dst = (second ? Wdn2 : Wdn1) + (size_t)(32 * nb) * DFF; t.ldd = DFF; t.k0 = 64 * kb; return; }
                r -= 2 * I_DN;
                if (r < I_IN) { const int nb = r % (INW / 32), kb = r / (INW / 32);
                    t.src = w_in + map_in(32 * nb); t.ldsrc = INW; t.gk = g_mix; t.cs = (32 * nb < 512) ? QSCALE : 1.0f; t.dst = Win + (size_t)(32 * nb) * DM; t.ldd = DM; t.k0 = 64 * kb; return; }
                r -= I_IN;
                if (r < I_A) { const int nb = r % 32, kb = r / 32; t.src = w_a + 32 * nb; t.ldsrc = DM; t.gk = nullptr; t.cs = 1.0f; t.dst = Wab + (size_t)(32 * nb) * KAB; t.ldd = KAB; t.k0 = 64 * kb; return; }
                r -= I_A;
                { const int nb = r % 32, kb = r / 32; t.src = w_o + 32 * nb; t.ldsrc = DM; t.gk = nullptr; t.cs = 1.0f; t.dst = Wo + (size_t)(32 * nb) * DM; t.ldd = DM; t.k0 = 64 * kb; }
            };
            f32x4 cur[8], nxt[8]; float gc[8], gn[8];
            TI tc, tn;
            int it = IT0 + GW_;
            if (it < IT1) { decode(it, tc);
#pragma unroll
                for (int i = 0; i < 8; ++i) { const int k = tc.k0 + 8 * i + kr; cur[i] = *(const f32x4*)(tc.src + (size_t)k * tc.ldsrc + 4 * c4); gc[i] = tc.gk ? tc.gk[k] : 1.0f; } }
            while (it < IT1) {
                const int itn = it + NGW_; const bool hn = itn < IT1;
                if (hn) { decode(itn, tn);
#pragma unroll
                    for (int i = 0; i < 8; ++i) { const int k = tn.k0 + 8 * i + kr; nxt[i] = *(const f32x4*)(tn.src + (size_t)k * tn.ldsrc + 4 * c4); gn[i] = tn.gk ? tn.gk[k] : 1.0f; } }
#pragma unroll
                for (int i = 0; i < 8; ++i) { const float sc = gc[i] * tc.cs; LAS float* p = scr + (8 * i + kr) * 33 + 4 * c4; p[0] = cur[i][0] * sc; p[1] = cur[i][1] * sc; p[2] = cur[i][2] * sc; p[3] = cur[i][3] * sc; }
                asm volatile("s_waitcnt lgkmcnt(0)" ::: "memory");
                { const int c = lane & 7;
#pragma unroll
                  for (int j = 0; j < 4; ++j) { const int n = (lane >> 3) + 8 * j; const LAS float* s = scr + (8 * c) * 33 + n;
                      u32x4 o; o.x = cvtpk(s[0 * 33], s[1 * 33]); o.y = cvtpk(s[2 * 33], s[3 * 33]); o.z = cvtpk(s[4 * 33], s[5 * 33]); o.w = cvtpk(s[6 * 33], s[7 * 33]);
                      st16(tc.dst + (size_t)n * tc.ldd + tc.k0 + 8 * c, o); } }
                asm volatile("s_waitcnt lgkmcnt(0)" ::: "memory");
                if (hn) { tc = tn;
#pragma unroll
                    for (int i = 0; i < 8; ++i) { cur[i] = nxt[i]; gc[i] = gn[i]; } }
                it = itn;
            }
        }
    };
    auto p0_xb = [&](const int GW_, const int NGW_) {
        {
            f32x4 v[4], w[4]; int m = GW_;
            if (m < MTOK) { const f32x4* xr = (const f32x4*)(x + (size_t)m * DM) + 2 * lane;
#pragma unroll
                for (int j = 0; j < 2; ++j) { v[2 * j] = xr[128 * j]; v[2 * j + 1] = xr[128 * j + 1]; } }
            while (m < MTOK) {
                const int mn = m + NGW_;
                if (mn < MTOK) { const f32x4* xr = (const f32x4*)(x + (size_t)mn * DM) + 2 * lane;
#pragma unroll
                    for (int j = 0; j < 2; ++j) { w[2 * j] = xr[128 * j]; w[2 * j + 1] = xr[128 * j + 1]; } }
                float s = 0.f;
#pragma unroll
                for (int j = 0; j < 4; ++j) s += (v[j][0] * v[j][0] + v[j][1] * v[j][1]) + (v[j][2] * v[j][2] + v[j][3] * v[j][3]);
                s = wave_sum(s);
#pragma unroll
                for (int j = 0; j < 2; ++j) st16(brow(XB, m, DM) + 512 * j + 8 * lane, pack8(v[2 * j], v[2 * j + 1]));
                if (lane == 0) *(f32x4*)(RS0 + (size_t)m * 4) = (f32x4){s, 0.f, 0.f, 0.f};
#pragma unroll
                for (int j = 0; j < 4; ++j) v[j] = w[j];
                m = mn;
            }
        }
    };
    auto p0_fold_tm = [&](const int GW_, const int NGW_) {
        {
            LAS float* tab = (LAS float*)(lds + 8 * 8448 + 8192 + wave * 4096);
            for (int item = GW_; item < 2048; item += NGW_) {
                const int kg = item >> 4, ng = item & 15, g = kg >> 5, j0 = (8 * kg) & 255, part = j0 >> 7, c0 = j0 & 127, n = 64 * ng + lane;
#pragma unroll
                for (int i = 0; i < 16; ++i) { const int idx = lane + 64 * i, cp = idx >> 3, e = idx & 7, ph = ((c0 + e) * cp) & 127; tab[idx] = part ? -cosT[(16 * ph - 512) & 2047] : cosT[16 * ph]; }
                asm volatile("s_waitcnt lgkmcnt(0)" ::: "memory");
                float a8[8];
#pragma unroll
                for (int e = 0; e < 8; ++e) a8[e] = 0.f;
                const float* wp = w_b + (size_t)(g * 128) * DM + n;
                float wa[16], wb[16];
#pragma unroll
                for (int i = 0; i < 16; ++i) wa[i] = wp[(size_t)i * DM];
#pragma unroll 1
                for (int cb = 0; cb < 128; cb += 32) {
#pragma unroll
                    for (int i = 0; i < 16; ++i) wb[i] = wp[(size_t)(cb + 16 + i) * DM];
#pragma unroll
                    for (int i = 0; i < 16; ++i) { const int cp = cb + i; const float w = wa[i]; const f32x4 t0 = *(const LAS f32x4*)(tab + cp * 8), t1 = *(const LAS f32x4*)(tab + cp * 8 + 4);
                        a8[0] += w * t0[0]; a8[1] += w * t0[1]; a8[2] += w * t0[2]; a8[3] += w * t0[3]; a8[4] += w * t1[0]; a8[5] += w * t1[1]; a8[6] += w * t1[2]; a8[7] += w * t1[3];
                        if ((i & 3) == 3) asm volatile("" : "+v"(a8[0]), "+v"(a8[1]), "+v"(a8[2]), "+v"(a8[3]), "+v"(a8[4]), "+v"(a8[5]), "+v"(a8[6]), "+v"(a8[7])); }
                    if (cb + 32 < 128) {
#pragma unroll
                        for (int i = 0; i < 16; ++i) wa[i] = wp[(size_t)(cb + 32 + i) * DM]; }
#pragma unroll
                    for (int i = 0; i < 16; ++i) { const int cp = cb + 16 + i; const float w = wb[i]; const f32x4 t0 = *(const LAS f32x4*)(tab + cp * 8), t1 = *(const LAS f32x4*)(tab + cp * 8 + 4);
                        a8[0] += w * t0[0]; a8[1] += w * t0[1]; a8[2] += w * t0[2]; a8[3] += w * t0[3]; a8[4] += w * t1[0]; a8[5] += w * t1[1]; a8[6] += w * t1[2]; a8[7] += w * t1[3];
                        if ((i & 3) == 3) asm volatile("" : "+v"(a8[0]), "+v"(a8[1]), "+v"(a8[2]), "+v"(a8[3]), "+v"(a8[4]), "+v"(a8[5]), "+v"(a8[6]), "+v"(a8[7])); }
                }
                const float sc = 0.08838834764831845f;
                u32x4 o; o.x = cvtpk(a8[0] * sc, a8[1] * sc); o.y = cvtpk(a8[2] * sc, a8[3] * sc); o.z = cvtpk(a8[4] * sc, a8[5] * sc); o.w = cvtpk(a8[6] * sc, a8[7] * sc);
                st16(Wab + (size_t)n * KAB + 512 + 8 * kg, o);
                asm volatile("s_waitcnt lgkmcnt(0)" ::: "memory");
            }
        }
    };
    auto p0_tm = [&](const int GW_, const int NGW_) {
        for (int idx = GW_ * 64 + lane; idx < 2048 * 256; idx += NGW_ * 64) {
            const int rT = idx >> 8, s0 = (idx & 255) * 8, part = rT >> 10, k = (rT == 1024) ? 1024 : (rT & 1023); const float sc = 0.022097086912079608f;
            float v[8];
#pragma unroll
            for (int e = 0; e < 8; ++e) { const int ph = (k * (s0 + e)) & 2047; v[e] = cosT[(part && rT != 1024) ? ((ph - 512) & 2047) : ph] * sc; }
            u32x4 o; o.x = cvtpk(v[0], v[1]); o.y = cvtpk(v[2], v[3]); o.z = cvtpk(v[4], v[5]); o.w = cvtpk(v[6], v[7]);
            st16(Tm + (size_t)rT * SEQ + s0, o);
        }
    };
    PH(0) {
        const int gw = vcu * 8 + wave, NGW = G * 8;
        for (int j = tid; j < 2048; j += 512) cosT[j] = cospif((float)j * (1.0f / 1024.0f));
        __syncthreads();
        if (wave & 1) p0_fold_tm(gw, NGW);
        p0_xb(gw, NGW);
        p0_transposes(0, I_UP, gw, NGW);
        if (!(wave & 1)) p0_fold_tm(gw, NGW);
        __syncthreads();
    }
    GRID_BAR(); STAMP(1);
    grp_pure = (G % 8 == 0) && (xb_ld(grp_census + (bar.x & 15u)) == (unsigned)(G / 8));

    PH(1) { SchedPlain S; S.T.init(MTOK, NUP, G, bx); S.A = (const char*)XB; S.Bt = (const char*)Wup1; S.tA = (size_t)256 * DM * 2; S.tB = (size_t)256 * DM * 2;
      EpiSwiGLU E{RS0, AFF}; pg8::gemm_phase<EpiSwiGLU, SchedPlain, true>(lds, pg8::GemmP{DM, DM, DM}, S, E); }
    if (2 * bx >= G) {
        const int gw = (bx - G / 2) * 8 + wave, NGW = (G - G / 2) * 8;
        for (int j = tid; j < 2048; j += 512) cosT[j] = cospif((float)j * (1.0f / 1024.0f));
        __syncthreads();
        p0_transposes(I_UP, NITEMS, gw, NGW);
        p0_tm(gw, NGW);
        __syncthreads();
    }
    GRID_BAR(); STAMP(2);
    PH(2) { SchedPlain S; S.T.init(MTOK, DM, G, bx); S.A = (const char*)AFF; S.Bt = (const char*)Wdn1; S.tA = (size_t)256 * DFF * 2; S.tB = (size_t)256 * DFF * 2;
      EpiResid<true> E{x, XB, RS1, 0.5f}; pg8::gemm_phase<EpiResid<true>, SchedPlain, false>(lds, pg8::GemmP{DFF, DFF, DFF}, S, E); }
    GROUP_BAR(); STAMP(3);
    PH(3) { SchedWin S; S.T.init(MTOK, 12 * 256, G, bx); S.X = (const char*)XB; S.W = (const char*)Win; S.tX = (size_t)256 * DM * 2; S.tW = (size_t)256 * DM * 2;
      EpiWin E{RS1, b_gate, QKV, FT, GATES}; pg8::gemm_phase<EpiWin, SchedWin, true>(lds, pg8::GemmP{DM, DM, DM}, S, E); }
    GROUP_BAR(); STAMP(4);
    { const int b = bx & 7, ci = bx >> 3;
      if (ci < 16) {
        PH(41) { SchedOne S; S.u0 = Unit{ci >> 1, ci & 1}; S.A = (const char*)(Tm + (size_t)(ci >> 1) * 256 * SEQ); S.Bt = (const char*)(FT + (size_t)b * SLAB_E + (size_t)(ci & 1) * 256 * SEQ);
          EpiDft E{AOPQ, b}; pg8::gemm_phase<EpiDft, SchedOne, false>(lds, pg8::GemmP{SEQ, SEQ, SEQ}, S, E); }
      } else {
        if (ci < 24) { SchedOne S; S.u0 = Unit{8 * b + (ci - 16), 12}; S.A = (const char*)(brow(XB, (8 * b + (ci - 16)) * 256, DM)); S.Bt = (const char*)(Win + (size_t)12 * 256 * DM);
          EpiWin E{RS1, b_gate, QKV, FT, GATES}; pg8::gemm_phase<EpiWin, SchedOne, false>(lds, pg8::GemmP{DM, DM, DM}, S, E); }
        const int na = ci < 24 ? 1 : 3, a0 = ci < 24 ? ci - 16 : 8 + 3 * (ci - 24);
        PH(42) { for (int r = 0; r < na; ++r) { const int a = a0 + r;
            att::attn_unit(lds, (LAS float*)(lds + BIAS_OFF), (LAS float*)(lds + WSF_OFF), QKV, AOPQ, sink, rel_bias, b, a & 1, a >> 1);
            asm volatile("s_waitcnt lgkmcnt(0)" ::: "memory"); __builtin_amdgcn_s_barrier(); } }
      }
    }
    GROUP_BAR(); STAMP(5);
    PH(5) { SchedPlain S; S.T.init(MTOK, DM, G, bx); S.A = (const char*)AOPQ; S.Bt = (const char*)Wab; S.tA = (size_t)256 * KAB * 2; S.tB = (size_t)256 * KAB * 2;
      EpiGate E{GATES}; pg8::gemm_phase<EpiGate, SchedPlain, false>(lds, pg8::GemmP{KAB, KAB, KAB}, S, E); }
    GROUP_BAR(); STAMP(6);
    PH(6) { SchedPlain S; S.T.init(MTOK, DM, G, bx); S.A = (const char*)GATES; S.Bt = (const char*)Wo; S.tA = (size_t)256 * 2048 * 2; S.tB = (size_t)256 * DM * 2;
      EpiResid<false> E{nullptr, XB, RS2, 1.0f}; pg8::gemm_phase<EpiResid<false>, SchedPlain, false>(lds, pg8::GemmP{DM, 2048, DM}, S, E); }
    GROUP_BAR(); STAMP(7);
    PH(7) { SchedPlain S; S.T.init(MTOK, NUP, G, bx); S.A = (const char*)XB; S.Bt = (const char*)Wup2; S.tA = (size_t)256 * DM * 2; S.tB = (size_t)256 * DM * 2;
      EpiSwiGLU E{RS2, AFF}; pg8::gemm_phase<EpiSwiGLU, SchedPlain, true>(lds, pg8::GemmP{DM, DM, DM}, S, E); }
    GROUP_BAR(); STAMP(8);
    PH(8) { SchedPlain S; S.T.init(MTOK, DM, G, bx); S.A = (const char*)AFF; S.Bt = (const char*)Wdn2; S.tA = (size_t)256 * DFF * 2; S.tB = (size_t)256 * DFF * 2;
      ++grp_gen; EpiFinal E{XB, out, RS3, g_final, 0.5f, grp_cnt, grp_gen * (unsigned)(G / 8), grp_pure, ctl + 1024 + XB_TMO};
      pg8::gemm_phase<EpiFinal, SchedPlain, false>(lds, pg8::GemmP{DFF, DFF, DFF}, S, E); }
    if (PROBE_K >= 0 && bx == 0 && tid == 0) { const unsigned long long t_sel = ((unsigned long long)MISC[17] << 32) | MISC[16], t_start = ((unsigned long long)MISC[19] << 32) | MISC[18]; const unsigned long long t_end = __builtin_amdgcn_s_memrealtime(), want = 4ull * (t_sel - t_start); while (__builtin_amdgcn_s_memrealtime() - t_end < want) __builtin_amdgcn_s_sleep(8); }
}

extern "C" void kernel_launch(void* const* d_in, const int* in_sizes, int n_in, void* d_out, int out_size, void* d_ws, size_t ws_size, hipStream_t stream) {
    static int grid = 0;
    if (grid == 0) {
        if (n_in != 16 || in_sizes[0] != MTOK * DM || out_size != MTOK * DM || ws_size < WS_END) { fprintf(stderr, "kernel_launch: unexpected shapes (n_in %d, ws %zu)\n", n_in, ws_size); grid = -1; return; }
        int dev = 0, cus = 0, per_cu = 0;
        if (hipGetDevice(&dev) != hipSuccess || hipDeviceGetAttribute(&cus, hipDeviceAttributeMultiprocessorCount, dev) != hipSuccess) { grid = -1; return; }
        if (hipFuncSetAttribute((const void*)mega_fwd, hipFuncAttributeMaxDynamicSharedMemorySize, LDS_BYTES) != hipSuccess) { fprintf(stderr, "kernel_launch: hipFuncSetAttribute failed\n"); grid = -1; return; }
        if (hipOccupancyMaxActiveBlocksPerMultiprocessor(&per_cu, (const void*)mega_fwd, 512, LDS_BYTES) != hipSuccess || per_cu < 1) { fprintf(stderr, "kernel_launch: occupancy query says %d\n", per_cu); }
        (void)hipGetLastError();
        grid = cus;
        if (grid != 256) { fprintf(stderr, "kernel_launch: needs 256 CUs, device has %d\n", cus); grid = -1; return; }
    }
    if (grid < 0) return;
    if (hipMemsetAsync((char*)d_ws + WS_CTL, 0, CTL_ZERO_BYTES, stream) != hipSuccess) return;
    Args a{};
    for (int i = 0; i < 16; ++i) a.in[i] = (const float*)d_in[i];
    a.out = (float*)d_out; a.ws = (unsigned char*)d_ws;
    hipLaunchKernelGGL(mega_fwd, dim3(grid), dim3(512), LDS_BYTES, stream, a);
}
```

```cpp
#include <hip/hip_runtime.h>
#include <cstdio>
#include <cstdint>
#include <cmath>

#ifndef PROBE_K
#define PROBE_K -1
#endif
#define LAS __attribute__((address_space(3)))
#define GAS __attribute__((address_space(1)))
typedef unsigned short bf16_t;
typedef short bf16x8 __attribute__((ext_vector_type(8)));
typedef float f32x4 __attribute__((ext_vector_type(4)));
typedef float f32x16 __attribute__((ext_vector_type(16)));
typedef unsigned u32x4 __attribute__((ext_vector_type(4)));
typedef float f32x2_t __attribute__((ext_vector_type(2)));
typedef __bf16 bf16x2_t __attribute__((ext_vector_type(2)));
typedef short s16x4 __attribute__((ext_vector_type(4)));

constexpr int DM = 1024, NB = 8, SEQ = 2048, MTOK = NB * SEQ, DFF = 2816, NUP = 2 * DFF, INW = 3328;
constexpr int KAB = 1536;
constexpr float LOG2E = 1.4426950408889634f;
constexpr float QSCALE = 0.125f * LOG2E;
constexpr float RMS_EPS = 1e-6f;
constexpr size_t SLAB = (size_t)23 << 20, SLAB_E = SLAB / 2;
__device__ __forceinline__ unsigned short* brow(unsigned short* base, int row, int pitch) { return base + (size_t)(row >> 11) * SLAB_E + (size_t)(row & 2047) * pitch; }
__device__ __forceinline__ const unsigned short* brow(const unsigned short* base, int row, int pitch) { return base + (size_t)(row >> 11) * SLAB_E + (size_t)(row & 2047) * pitch; }

__device__ __forceinline__ unsigned cvtpk(float lo, float hi) { f32x2_t v = {lo, hi}; bf16x2_t b = __builtin_convertvector(v, bf16x2_t); return __builtin_bit_cast(unsigned, b); }
__device__ __forceinline__ u32x4 pack8(f32x4 a, f32x4 b) { u32x4 w; w.x = cvtpk(a[0], a[1]); w.y = cvtpk(a[2], a[3]); w.z = cvtpk(b[0], b[1]); w.w = cvtpk(b[2], b[3]); return w; }
#ifndef WT_STORES
#define WT_STORES 0
#endif
__device__ __forceinline__ void st16(void* p, u32x4 v) {
#if WT_STORES
    asm volatile("global_store_dwordx4 %0, %1, off sc1\n\ts_nop 1" :: "v"(p), "v"(v) : "memory");
#else
    *(u32x4*)p = v;
#endif
}
__device__ __forceinline__ void st16f(void* p, f32x4 v) { st16(p, __builtin_bit_cast(u32x4, v)); }
__device__ __forceinline__ void unpack8(u32x4 w, f32x4& a, f32x4& b) {
    a[0] = __builtin_bit_cast(float, w.x << 16); a[1] = __builtin_bit_cast(float, w.x & 0xffff0000u); a[2] = __builtin_bit_cast(float, w.y << 16); a[3] = __builtin_bit_cast(float, w.y & 0xffff0000u);
    b[0] = __builtin_bit_cast(float, w.z << 16); b[1] = __builtin_bit_cast(float, w.z & 0xffff0000u); b[2] = __builtin_bit_cast(float, w.w << 16); b[3] = __builtin_bit_cast(float, w.w & 0xffff0000u);
}
__device__ __forceinline__ float bf2f(unsigned short h) { return __builtin_bit_cast(float, (unsigned)h << 16); }
__device__ __forceinline__ float row_rinv(const float* RS, int row) { const f32x4 p = *(const f32x4*)(RS + 4 * (size_t)row); return rsqrtf(((p[0] + p[1]) + (p[2] + p[3])) * (1.0f / DM) + RMS_EPS); }

namespace pg8 {
constexpr int BM = 256, BK = 64, HALF = 128, HTB = HALF * BK * 2, STAGE_BYTES = 8 * HTB, NXCD = 8, WGM = 8;
__host__ __device__ __forceinline__ int lds_byte(int r, int c) { return (r >> 3) * 1024 + (r & 7) * 128 + (((c >> 3) ^ ((r >> 1) & 7)) * 16) + (c & 7) * 2; }
__host__ __device__ __forceinline__ void stage_rc(int b, int& R, int& C) { const int st = b / 1024, ob = b % 1024; R = st * 8 + (ob >> 7); C = ((((ob >> 4) & 7) ^ ((R >> 1) & 7)) * 8); }
__host__ __device__ __forceinline__ int perm32(int rho) { const int n = rho >> 4, i = rho & 15; return 8 * (i >> 2) + 4 * n + (i & 3); }

struct Unit { int pm, pn; };
struct GemmP { int K, lda, ldb; };

struct TileOrder {
    int nM, nN, nwg, G, c;
    __device__ void init(int M, int N, int G_, int c_) { nM = M / BM; nN = N / BM; nwg = nM * nN; G = G_; c = c_; }
    __device__ bool tile(int i, Unit& u) const {
        const long L = (long)i * G + c; if (L >= nwg) return false;
        int wgid = (int)L; { const int q = nwg / NXCD, r = nwg % NXCD, xcd = wgid % NXCD, off = wgid / NXCD; wgid = (xcd < r ? xcd * (q + 1) : r * (q + 1) + (xcd - r) * q) + off; }
        const int nig = WGM * nN, gid = wgid / nig, fm = gid * WGM, gsz = (nM - fm) < WGM ? (nM - fm) : WGM;
        u.pm = fm + ((wgid % nig) % gsz); u.pn = (wgid % nig) / gsz; return true;
    }
};

template <class Epi, class Sched, bool ALIGN_EPI>
__device__ __forceinline__ void gemm_phase(LAS unsigned char* lds, const GemmP g, const Sched& S, const Epi& E) {
    int tid = threadIdx.x; asm volatile("" : "+v"(tid));
    const int wid = __builtin_amdgcn_readfirstlane(tid >> 6), lane = tid & 63, wr = wid >> 2, wc = wid & 3, fr = lane & 15, fq = lane >> 4;
    const int K = g.K, nt = K / BK;
    unsigned voffA[2], voffB[2];
#pragma unroll
    for (int i = 0; i < 2; ++i) { int R, C; stage_rc(tid * 16 + i * 8192, R, C); const int Rb = (R & ~31) + perm32(R & 31);
        voffA[i] = (unsigned)(R * g.lda + C) * 2u; voffB[i] = (unsigned)(Rb * g.ldb + C) * 2u; }
    const size_t kstep = (size_t)(BK * 2);
    const size_t hstepA = (size_t)HALF * g.lda * 2, hstepB = (size_t)HALF * g.ldb * 2;
    const unsigned ldsw = (unsigned)wid * 1024u;
    const int aoffk[2] = {lds_byte(wr * 64 + fr, fq * 8), lds_byte(wr * 64 + fr, 32 + fq * 8)}, boffk[2] = {lds_byte(wc * 32 + fr, fq * 8), lds_byte(wc * 32 + fr, 32 + fq * 8)};
#define PG8_SA(b, h) (((b) * 2 + (h)) * HTB)
#define PG8_SB(b, h) ((4 + (b) * 2 + (h)) * HTB)
#define PG8_STAGE(bufoff, gbase, voff) do { _Pragma("unroll") for (int _i = 0; _i < 2; ++_i) \
        __builtin_amdgcn_global_load_lds((const unsigned*)((const char*)(gbase) + (voff)[_i]), (LAS unsigned*)(lds + (bufoff) + ldsw + _i * 8192), 16, 0, 0); } while (0)
#define PG8_LDA(dst, b, h) do { _Pragma("unroll") for (int m = 0; m < 4; ++m) _Pragma("unroll") for (int k = 0; k < 2; ++k) dst[m][k] = *(const LAS bf16x8*)(lds + PG8_SA(b, h) + aoffk[k] + m * 2048); } while (0)
#define PG8_LDB(dst, b, h) do { _Pragma("unroll") for (int n = 0; n < 2; ++n) _Pragma("unroll") for (int k = 0; k < 2; ++k) dst[n][k] = *(const LAS bf16x8*)(lds + PG8_SB(b, h) + boffk[k] + n * 2048); } while (0)
#define PG8_MMA(ai, bj, At, Bt) do { __builtin_amdgcn_s_setprio(1); _Pragma("unroll") for (int m = 0; m < 4; ++m) _Pragma("unroll") for (int n = 0; n < 2; ++n) _Pragma("unroll") for (int k = 0; k < 2; ++k) \
        acc[ai][bj][m][n] = __builtin_amdgcn_mfma_f32_16x16x32_bf16(Bt[n][k], At[m][k], acc[ai][bj][m][n], 0, 0, 0); __builtin_amdgcn_s_setprio(0); } while (0)
#define PG8_WAIT_V(n) asm volatile("s_waitcnt vmcnt(" #n ")" ::: "memory")
#define PG8_WAIT_L(n) asm volatile("s_waitcnt lgkmcnt(" #n ")" ::: "memory")
#define PG8_BAR __builtin_amdgcn_s_barrier()
#define PG8_SCHED __builtin_amdgcn_sched_barrier(0)
    Unit cur, nxt; int ui = 0;
    if (!S.next(0, cur)) return;
    f32x4 acc[2][2][4][2];
#pragma unroll
    for (int a = 0; a < 2; ++a)
#pragma unroll
        for (int b = 0; b < 2; ++b)
#pragma unroll
            for (int m = 0; m < 4; ++m)
#pragma unroll
                for (int n = 0; n < 2; ++n) acc[a][b][m][n] = (f32x4){0.f, 0.f, 0.f, 0.f};
    bf16x8 At[4][2], B0[2][2], B1[2][2];
    const char* cA = S.opA(cur); const char* cB = S.opB(cur);
    PG8_STAGE(PG8_SB(0, 0), cB, voffB); PG8_STAGE(PG8_SB(0, 1), cB + hstepB, voffB); PG8_STAGE(PG8_SA(0, 0), cA, voffA); PG8_STAGE(PG8_SA(0, 1), cA + hstepA, voffA);
    if (wr == 1) PG8_BAR;
    PG8_WAIT_V(2); PG8_BAR;
    PG8_STAGE(PG8_SB(1, 0), cB + kstep, voffB); PG8_STAGE(PG8_SA(1, 0), cA + kstep, voffA); PG8_STAGE(PG8_SB(1, 1), cB + hstepB + kstep, voffB);
    PG8_WAIT_V(6); PG8_BAR;
    for (;;) {
        const bool has_next = S.next(ui + 1, nxt);
        const char* nA = has_next ? S.opA(nxt) : cA; const char* nB = has_next ? S.opB(nxt) : cB;
        for (int t = 0; t < nt; t += 2) {
            const bool last = (t == nt - 2);
            const char* a1 = cA + (size_t)(t + 1) * kstep;
            const char* a2 = last ? nA : cA + (size_t)(t + 2) * kstep; const char* b2 = last ? nB : cB + (size_t)(t + 2) * kstep;
            const char* a3 = a2 + kstep; const char* b3 = b2 + kstep;
            if constexpr (Epi::MID_T >= 0) { if (t == Epi::MID_T) E.mid(acc, cur, wr, wc, fr, fq); }
            PG8_LDB(B0, 0, 0); PG8_LDB(B1, 0, 1); PG8_SCHED; PG8_LDA(At, 0, 0); PG8_STAGE(PG8_SA(1, 1), a1 + hstepA, voffA);
            PG8_WAIT_V(8); PG8_WAIT_L(0); PG8_BAR; PG8_MMA(0, 0, At, B0); PG8_MMA(0, 1, At, B1); PG8_BAR; PG8_SCHED;
            PG8_LDA(At, 0, 1); PG8_STAGE(PG8_SB(0, 0), b2, voffB); PG8_STAGE(PG8_SB(0, 1), b2 + hstepB, voffB); PG8_STAGE(PG8_SA(0, 0), a2, voffA);
            PG8_WAIT_V(8); PG8_WAIT_L(0); PG8_BAR; PG8_MMA(1, 0, At, B0); PG8_MMA(1, 1, At, B1); PG8_BAR; PG8_SCHED;
            PG8_LDB(B0, 1, 0); PG8_LDB(B1, 1, 1); PG8_SCHED; PG8_LDA(At, 1, 0); PG8_STAGE(PG8_SA(0, 1), a2 + hstepA, voffA);
            PG8_WAIT_V(8); PG8_WAIT_L(0); PG8_BAR; PG8_MMA(0, 0, At, B0); PG8_MMA(0, 1, At, B1); PG8_BAR; PG8_SCHED;
            PG8_LDA(At, 1, 1); PG8_STAGE(PG8_SB(1, 0), b3, voffB); PG8_STAGE(PG8_SB(1, 1), b3 + hstepB, voffB); PG8_STAGE(PG8_SA(1, 0), a3, voffA);
            PG8_WAIT_V(8); PG8_WAIT_L(0); PG8_BAR; PG8_MMA(1, 0, At, B0); PG8_MMA(1, 1, At, B1); PG8_BAR; PG8_SCHED;
        }
        if constexpr (ALIGN_EPI) { if (wr == 0) PG8_BAR; }
        if constexpr (!Epi::AFTER_DRAIN) { E(acc, cur, wr, wc, fr, fq); }
        if (!has_next) break;
#pragma unroll
        for (int a = 0; a < 2; ++a)
#pragma unroll
            for (int b = 0; b < 2; ++b)
#pragma unroll
                for (int m = 0; m < 4; ++m)
#pragma unroll
                    for (int n = 0; n < 2; ++n) acc[a][b][m][n] = (f32x4){0.f, 0.f, 0.f, 0.f};
        cur = nxt; cA = nA; cB = nB; ++ui;
        if constexpr (ALIGN_EPI) { if (wr == 1) PG8_BAR; }
    }
    PG8_WAIT_V(0);
    if constexpr (!ALIGN_EPI) { if (wr == 0) PG8_BAR; }
    PG8_BAR;
    if constexpr (Epi::AFTER_DRAIN) { E.fused(acc, cur, wr, wc, fr, fq, lds, wid, lane); }
#undef PG8_SA
#undef PG8_SB
#undef PG8_STAGE
#undef PG8_LDA
#undef PG8_LDB
#undef PG8_MMA
#undef PG8_WAIT_V
#undef PG8_WAIT_L
#undef PG8_BAR
#undef PG8_SCHED
}
}
using pg8::Unit;
typedef f32x4 Acc[2][2][4][2];

struct SchedPlain {
    pg8::TileOrder T; const char* A; const char* Bt; size_t tA, tB;
    __device__ __forceinline__ bool next(int i, Unit& u) const { return T.tile(i, u); }
    __device__ __forceinline__ const char* opA(const Unit& u) const { return A + (size_t)(u.pm >> 3) * SLAB + (size_t)(u.pm & 7) * tA; }
    __device__ __forceinline__ const char* opB(const Unit& u) const { return Bt + (size_t)u.pn * tB; }
};
struct SchedWin {
    pg8::TileOrder T; const char* X; const char* W; size_t tX, tW;
    __device__ __forceinline__ bool next(int i, Unit& u) const { return T.tile(i, u); }
    __device__ __forceinline__ const char* xp(const Unit& u) const { return X + (size_t)(u.pm >> 3) * SLAB + (size_t)(u.pm & 7) * tX; }
    __device__ __forceinline__ const char* opA(const Unit& u) const { return (u.pn == 3 || u.pn == 4) ? W + (size_t)u.pn * tW : xp(u); }
    __device__ __forceinline__ const char* opB(const Unit& u) const { return (u.pn == 3 || u.pn == 4) ? xp(u) : W + (size_t)u.pn * tW; }
};
struct SchedOne {
    const char* A; const char* Bt; Unit u0;
    __device__ __forceinline__ bool next(int i, Unit& u) const { if (i > 0) return false; u = u0; return true; }
    __device__ __forceinline__ const char* opA(const Unit&) const { return A; }
    __device__ __forceinline__ const char* opB(const Unit&) const { return Bt; }
};

struct EpiSwiGLU {
    static constexpr bool AFTER_DRAIN = false; static constexpr int MID_T = -1;
    const float* RS; bf16_t* O;
    __device__ __forceinline__ void mid(Acc&, const Unit&, int, int, int, int) const {}
    __device__ __forceinline__ void operator()(const Acc& acc, const Unit& u, int wr, int wc, int fr, int fq) const {
        asm volatile("" : "+v"(fr), "+v"(fq));
        const int row0 = u.pm * 256 + wr * 64 + fr, col0 = u.pn * 128 + wc * 32 + 8 * fq;
        float rv[2][4];
#pragma unroll
        for (int ai = 0; ai < 2; ++ai)
#pragma unroll
            for (int m = 0; m < 4; ++m) rv[ai][m] = row_rinv(RS, row0 + ai * 128 + m * 16);
#pragma unroll
        for (int ai = 0; ai < 2; ++ai)
#pragma unroll
            for (int m = 0; m < 4; ++m) {
                const int row = row0 + ai * 128 + m * 16; const float r = rv[ai][m];
                f32x4 o[2];
#pragma unroll
                for (int n = 0; n < 2; ++n) { const f32x4 g = acc[ai][0][m][n] * r, up = acc[ai][1][m][n] * r;
#pragma unroll
                    for (int j = 0; j < 4; ++j) { const float e = __builtin_amdgcn_exp2f(-g[j] * LOG2E); o[n][j] = g[j] * up[j] * __builtin_amdgcn_rcpf(1.0f + e); } }
                st16(brow(O, row, DFF) + col0, pack8(o[0], o[1]));
            }
    }
};
template <bool XIN_F32> struct EpiResid {
    static constexpr bool AFTER_DRAIN = true; static constexpr int MID_T = -1;
    const float* xin; bf16_t* XB; float* RSo; float alpha;
    __device__ __forceinline__ void mid(Acc&, const Unit&, int, int, int, int) const {}
    __device__ __forceinline__ void operator()(const Acc&, const Unit&, int, int, int, int) const {}
    __device__ __forceinline__ void fused(Acc& acc, const Unit& u, int wr, int wc, int fr, int fq, LAS unsigned char* lds, int wid, int lane) const {
        asm volatile("" : "+v"(fr), "+v"(fq));
        LAS float* P = (LAS float*)lds;
#pragma unroll
        for (int ai = 0; ai < 2; ++ai) {
            u32x4 xr[4][2]; f32x4 xf[2][2][2];
            if constexpr (!XIN_F32) {
#pragma unroll
                for (int m = 0; m < 4; ++m)
#pragma unroll
                    for (int bj = 0; bj < 2; ++bj) xr[m][bj] = *(const u32x4*)(brow(XB, u.pm * 256 + ai * 128 + wr * 64 + m * 16 + fr, DM) + u.pn * 256 + bj * 128 + wc * 32 + 8 * fq);
            }
#pragma unroll
            for (int m = 0; m < 4; ++m) {
                const int rl = ai * 128 + wr * 64 + m * 16 + fr, row = u.pm * 256 + rl; float ss = 0.f;
                if constexpr (XIN_F32) { if ((m & 1) == 0) {
#pragma unroll
                    for (int mm = 0; mm < 2; ++mm)
#pragma unroll
                        for (int bj = 0; bj < 2; ++bj) { const size_t off = (size_t)(row + 16 * mm) * DM + u.pn * 256 + bj * 128 + wc * 32 + 8 * fq; xf[mm][bj][0] = *(const f32x4*)(xin + off); xf[mm][bj][1] = *(const f32x4*)(xin + off + 4); } } }
#pragma unroll
                for (int bj = 0; bj < 2; ++bj) {
                    const int col = u.pn * 256 + bj * 128 + wc * 32 + 8 * fq;
                    bf16_t* xb = brow(XB, row, DM) + col;
                    f32x4 x0, x1;
                    if constexpr (XIN_F32) { x0 = xf[m & 1][bj][0]; x1 = xf[m & 1][bj][1]; }
                    else unpack8(xr[m][bj], x0, x1);
                    x0 = x0 + acc[ai][bj][m][0] * alpha; x1 = x1 + acc[ai][bj][m][1] * alpha;
                    ss += (x0[0] * x0[0] + x0[1] * x0[1]) + (x0[2] * x0[2] + x0[3] * x0[3]) + (x1[0] * x1[0] + x1[1] * x1[1]) + (x1[2] * x1[2] + x1[3] * x1[3]);
                    st16(xb, pack8(x0, x1));
                }
                ss += __shfl_xor(ss, 16); ss += __shfl_xor(ss, 32);
                if (fq == 0) P[rl * 4 + wc] = ss;
            }
        }
        asm volatile("s_waitcnt lgkmcnt(0)" ::: "memory"); __builtin_amdgcn_s_barrier(); asm volatile("" ::: "memory");
        const int tid = wid * 64 + lane;
        if (tid < 256) { const f32x4 p = *(const LAS f32x4*)(P + tid * 4); RSo[(size_t)(u.pm * 256 + tid) * 4 + u.pn] = (p[0] + p[1]) + (p[2] + p[3]); }
    }
};
struct EpiWin {
    static constexpr bool AFTER_DRAIN = false; static constexpr int MID_T = -1;
    const float* RS; const float* bg; bf16_t* QKV; bf16_t* FT; bf16_t* GATES;
    __device__ __forceinline__ void mid(Acc&, const Unit&, int, int, int, int) const {}
    __device__ __forceinline__ void operator()(const Acc& acc, const Unit& u, int wr, int wc, int fr, int fq) const {
        asm volatile("" : "+v"(fr), "+v"(fq));
        if (u.pn < 3) {
            const int row0 = u.pm * 256 + wr * 64 + fr, col0 = u.pn * 256 + wc * 32 + 8 * fq;
            float rv[2][4];
#pragma unroll
            for (int ai = 0; ai < 2; ++ai)
#pragma unroll
                for (int m = 0; m < 4; ++m) rv[ai][m] = row_rinv(RS, row0 + ai * 128 + m * 16);
#pragma unroll
            for (int ai = 0; ai < 2; ++ai)
#pragma unroll
                for (int m = 0; m < 4; ++m) { const int row = row0 + ai * 128 + m * 16; const float r = rv[ai][m];
#pragma unroll
                    for (int bj = 0; bj < 2; ++bj) st16(brow(QKV, row, 768) + col0 + bj * 128, pack8(acc[ai][bj][m][0] * r, acc[ai][bj][m][1] * r)); }
        } else if (u.pn < 5) {
            f32x4 rt[2][2];
#pragma unroll
            for (int bj = 0; bj < 2; ++bj)
#pragma unroll
                for (int n = 0; n < 2; ++n)
#pragma unroll
                    for (int j = 0; j < 4; ++j) rt[bj][n][j] = row_rinv(RS, u.pm * 256 + bj * 128 + wc * 32 + 8 * fq + 4 * n + j);
            const int b = u.pm >> 3, s0 = (u.pm & 7) * 256 + wc * 32 + 8 * fq;
#pragma unroll
            for (int ai = 0; ai < 2; ++ai)
#pragma unroll
                for (int m = 0; m < 4; ++m) { const int ch = (u.pn - 3) * 256 + ai * 128 + wr * 64 + m * 16 + fr; bf16_t* base = FT + (size_t)b * SLAB_E + (size_t)ch * SEQ + s0;
#pragma unroll
                    for (int bj = 0; bj < 2; ++bj) st16(base + bj * 128, pack8(acc[ai][bj][m][0] * rt[bj][0], acc[ai][bj][m][1] * rt[bj][1])); }
        } else {
            const int c0 = (u.pn - 5) * 128 + wc * 32 + 8 * fq, row0 = u.pm * 256 + wr * 64 + fr;
            f32x4 ba[2], bb[2];
#pragma unroll
            for (int n = 0; n < 2; ++n) { ba[n] = *(const f32x4*)(bg + c0 + 4 * n); bb[n] = *(const f32x4*)(bg + DM + c0 + 4 * n); }
            float rv[2][4];
#pragma unroll
            for (int ai = 0; ai < 2; ++ai)
#pragma unroll
                for (int m = 0; m < 4; ++m) rv[ai][m] = row_rinv(RS, row0 + ai * 128 + m * 16);
#pragma unroll
            for (int ai = 0; ai < 2; ++ai)
#pragma unroll
                for (int m = 0; m < 4; ++m) { const int row = row0 + ai * 128 + m * 16; const float r = rv[ai][m];
                    f32x4 ra[2], gb[2];
#pragma unroll
                    for (int n = 0; n < 2; ++n) { const f32x4 za = acc[ai][0][m][n] * r + ba[n], zb = acc[ai][1][m][n] * r + bb[n];
#pragma unroll
                        for (int j = 0; j < 4; ++j) { const float ea = __builtin_amdgcn_exp2f(-za[j] * LOG2E), eb = __builtin_amdgcn_exp2f(-zb[j] * LOG2E);
                            ra[n][j] = (1.0f + eb) * __builtin_amdgcn_rcpf(1.0f + ea); gb[n][j] = __builtin_amdgcn_rcpf(1.0f + eb); } }
                    bf16_t* gp = brow(GATES, row, 2048) + c0; st16(gp, pack8(ra[0], ra[1])); st16(gp + DM, pack8(gb[0], gb[1])); }
        }
    }
};
struct EpiDft {
    static constexpr bool AFTER_DRAIN = false; static constexpr int MID_T = -1;
    bf16_t* AOPQ; int b;
    __device__ __forceinline__ void mid(Acc&, const Unit&, int, int, int, int) const {}
    __device__ __forceinline__ void operator()(const Acc& acc, const Unit& u, int wr, int wc, int fr, int fq) const {
        asm volatile("" : "+v"(fr), "+v"(fq));
        const int part = u.pm >> 2, k0 = (u.pm & 3) * 256 + wr * 64 + fr;
        bf16_t* ab = AOPQ + (size_t)b * SLAB_E + 512 + wc * 32 + 8 * fq;
#pragma unroll
        for (int ai = 0; ai < 2; ++ai)
#pragma unroll
            for (int m = 0; m < 4; ++m) { const int k = k0 + ai * 128 + m * 16;
#pragma unroll
                for (int bj = 0; bj < 2; ++bj) { const int cg = (u.pn * 2 + bj) * 256; const f32x4 v0 = acc[ai][bj][m][0], v1 = acc[ai][bj][m][1];
                    if (part == 0) { const u32x4 w = pack8(v0, v1); st16(ab + (size_t)k * KAB + cg, w); if (k != 0) st16(ab + (size_t)(SEQ - k) * KAB + cg, w); }
                    else if (k != 0) { st16(ab + (size_t)k * KAB + cg + 128, pack8(v0, v1)); st16(ab + (size_t)(SEQ - k) * KAB + cg + 128, pack8(-v0, -v1)); }
                    else { const u32x4 z = (u32x4){0u, 0u, 0u, 0u}; st16(ab + (size_t)1024 * KAB + cg, pack8(v0, v1)); st16(ab + cg + 128, z); st16(ab + (size_t)1024 * KAB + cg + 128, z); } } }
    }
};
struct EpiGate {
    static constexpr bool AFTER_DRAIN = false; static constexpr int MID_T = 8;
    bf16_t* GATES;
    __device__ __forceinline__ void scale(Acc& acc, const Unit& u, int wr, int wc, int fr, int fq, int goff) const {
        asm volatile("" : "+v"(fr), "+v"(fq));
        u32x4 w[2][4][2];
#pragma unroll
        for (int ai = 0; ai < 2; ++ai)
#pragma unroll
            for (int m = 0; m < 4; ++m)
#pragma unroll
                for (int bj = 0; bj < 2; ++bj) w[ai][m][bj] = *(const u32x4*)(brow(GATES, u.pm * 256 + ai * 128 + wr * 64 + m * 16 + fr, 2048) + goff + u.pn * 256 + bj * 128 + wc * 32 + 8 * fq);
#pragma unroll
        for (int ai = 0; ai < 2; ++ai)
#pragma unroll
            for (int m = 0; m < 4; ++m)
#pragma unroll
                for (int bj = 0; bj < 2; ++bj) { f32x4 s0, s1; unpack8(w[ai][m][bj], s0, s1);
                    acc[ai][bj][m][0] = acc[ai][bj][m][0] * s0; acc[ai][bj][m][1] = acc[ai][bj][m][1] * s1; }
    }
    __device__ __forceinline__ void mid(Acc& acc, const Unit& u, int wr, int wc, int fr, int fq) const { scale(acc, u, wr, wc, fr, fq, 0); }
    __device__ __forceinline__ void operator()(Acc& acc, const Unit& u, int wr, int wc, int fr, int fq) const {
        scale(acc, u, wr, wc, fr, fq, DM);
#pragma unroll
        for (int ai = 0; ai < 2; ++ai)
#pragma unroll
            for (int m = 0; m < 4; ++m) { const int row = u.pm * 256 + ai * 128 + wr * 64 + m * 16 + fr;
#pragma unroll
                for (int bj = 0; bj < 2; ++bj) st16(brow(GATES, row, 2048) + u.pn * 256 + bj * 128 + wc * 32 + 8 * fq, pack8(acc[ai][bj][m][0], acc[ai][bj][m][1])); }
    }
};

namespace att {
constexpr int LDS_K = 0, LDS_V = 49152, LDS_OST = 98304;
__device__ __forceinline__ int crow(int r, int hi) { return (r & 3) + 8 * (r >> 2) + 4 * hi; }
__device__ __forceinline__ int t5_bucket(int rel) {
    const int n = rel < 0 ? -rel : rel; int b;
    if (n < 8) b = n; else if (n < 12) b = 8; else if (n < 16) b = 9; else if (n < 23) b = 10; else if (n < 32) b = 11; else if (n < 46) b = 12; else if (n < 64) b = 13; else if (n < 91) b = 14; else b = 15;
    return b + (rel > 0 ? 16 : 0);
}
__device__ __forceinline__ s16x4 vtr(const LAS unsigned char* p) { typedef short v4i16_t __attribute__((ext_vector_type(4))); return __builtin_bit_cast(s16x4, __builtin_amdgcn_ds_read_tr16_b64_v4i16((LAS v4i16_t*)p)); }
__device__ __forceinline__ unsigned short f2bf(float f) { unsigned u = __builtin_bit_cast(unsigned, f); return (unsigned short)((u + 0x7fffu + ((u >> 16) & 1u)) >> 16); }

__device__ __forceinline__ void attn_unit(LAS unsigned char* ring, LAS float* biasT  , LAS float* wsfAll  , const bf16_t* QKV, bf16_t* AOPQ,
                                          const float* sink, const float* relb, int b, int kvh, int n) {
    const int tid = threadIdx.x, lane = tid & 63, r32 = lane & 31, hi = lane >> 5, wid = __builtin_amdgcn_readfirstlane(tid >> 6);
    for (int t = tid; t < 4 * 512; t += 512) { const int g = t >> 9, rel = (t & 511) - 256; biasT[t] = (rel >= -128 && rel <= 128) ? relb[t5_bucket(rel) * 8 + kvh * 4 + g] * LOG2E : -INFINITY; }
    const int tlo = (n == 0) ? 2 : 0, thi = (n == 15) ? 3 : 5;
    const size_t rowb = 0; QKV += (size_t)b * SLAB_E; AOPQ += (size_t)b * SLAB_E; const int key0 = 128 * (n - 1);
    for (int t = tlo; t <= thi; ++t) {
        const bf16_t* ks = QKV + (rowb + key0 + 64 * t + lane) * 768 + 512 + kvh * 64 + wid * 8;
        __builtin_amdgcn_global_load_lds((const unsigned*)ks, (LAS unsigned*)(ring + LDS_K + t * 8192 + wid * 1024), 16, 0, 0);
        const bf16_t* vs = QKV + (rowb + key0 + 64 * t + 16 * (wid & 3) + (lane >> 2)) * 768 + 640 + kvh * 64 + (wid >> 2) * 32 + (lane & 3) * 8;
        __builtin_amdgcn_global_load_lds((const unsigned*)vs, (LAS unsigned*)(ring + LDS_V + t * 8192 + wid * 1024), 16, 0, 0);
    }
    asm volatile("s_waitcnt vmcnt(0) lgkmcnt(0)" ::: "memory"); __builtin_amdgcn_s_barrier(); asm volatile("" ::: "memory");
    const int g = wid >> 1, h = kvh * 4 + g;
    LAS float* wsf = wsfAll + wid * 128; const LAS float* bT = biasT + g * 512;
    const float sinkl = sink[h] * LOG2E;
    const int q0b = (wid & 1) * 64;
    bf16x8 qr[2][4]; float m_run[2], l_run[2]; f32x16 o0[2], o1[2];
#pragma unroll
    for (int qq = 0; qq < 2; ++qq) {
        const bf16_t* qp = QKV + (rowb + 128 * n + q0b + 32 * qq + r32) * 768 + h * 64 + hi * 8;
#pragma unroll
        for (int d0 = 0; d0 < 4; ++d0) qr[qq][d0] = *(const bf16x8*)(qp + d0 * 16);
        m_run[qq] = sinkl; l_run[qq] = hi ? 0.f : 1.f;
#pragma unroll
        for (int r = 0; r < 16; ++r) { o0[qq][r] = 0.f; o1[qq][r] = 0.f; }
    }
    int t0 = q0b >> 6, t1 = (287 + q0b) >> 6; t0 = t0 < tlo ? tlo : t0; t1 = t1 > thi ? thi : t1;
    for (int t = t0; t <= t1; ++t) {
        f32x16 p0[2], p1[2];
#pragma unroll
        for (int qq = 0; qq < 2; ++qq)
#pragma unroll
            for (int r = 0; r < 16; ++r) { p0[qq][r] = 0.f; p1[qq][r] = 0.f; }
        const LAS unsigned char* kb = ring + LDS_K + t * 8192 + hi * 1024 + r32 * 16;
#pragma unroll
        for (int d0 = 0; d0 < 4; ++d0) { const bf16x8 k0 = *(const LAS bf16x8*)(kb + d0 * 2048), k1 = *(const LAS bf16x8*)(kb + d0 * 2048 + 512);
#pragma unroll
            for (int qq = 0; qq < 2; ++qq) { p0[qq] = __builtin_amdgcn_mfma_f32_32x32x16_bf16(k0, qr[qq][d0], p0[qq], 0, 0, 0); p1[qq] = __builtin_amdgcn_mfma_f32_32x32x16_bf16(k1, qr[qq][d0], p1[qq], 0, 0, 0); } }
        u32x4 pw[2][4];
#pragma unroll
        for (int qq = 0; qq < 2; ++qq) {
            const int qpos = 128 + q0b + 32 * qq + r32;
            const LAS float* bp = bT + (64 * t - qpos + 256 + 4 * hi);
            float tm = -INFINITY;
#pragma unroll
            for (int r = 0; r < 16; ++r) { const int o = (r & 3) + 8 * (r >> 2);
                p0[qq][r] += bp[o]; p1[qq][r] += bp[o + 32];
                tm = fmaxf(tm, fmaxf(p0[qq][r], p1[qq][r])); }
            tm = fmaxf(tm, __shfl_xor(tm, 32));
            const float mn = fmaxf(m_run[qq], tm), alpha = __builtin_amdgcn_exp2f(m_run[qq] - mn); m_run[qq] = mn;
            float rs = 0.f;
#pragma unroll
            for (int r = 0; r < 16; ++r) { p0[qq][r] = __builtin_amdgcn_exp2f(p0[qq][r] - mn); p1[qq][r] = __builtin_amdgcn_exp2f(p1[qq][r] - mn); rs += p0[qq][r] + p1[qq][r]; }
            l_run[qq] = l_run[qq] * alpha + rs;
            if (__any(alpha != 1.0f)) {
                if (hi == 0) wsf[32 * qq + r32] = alpha;
                asm volatile("s_waitcnt lgkmcnt(0)" ::: "memory");
#pragma unroll
                for (int r = 0; r < 16; ++r) { const float a = wsf[32 * qq + crow(r, hi)]; o0[qq][r] *= a; o1[qq][r] *= a; }
            }
            pw[qq][0] = (u32x4){cvtpk(p0[qq][0], p0[qq][1]), cvtpk(p0[qq][2], p0[qq][3]), cvtpk(p0[qq][4], p0[qq][5]), cvtpk(p0[qq][6], p0[qq][7])};
            pw[qq][1] = (u32x4){cvtpk(p0[qq][8], p0[qq][9]), cvtpk(p0[qq][10], p0[qq][11]), cvtpk(p0[qq][12], p0[qq][13]), cvtpk(p0[qq][14], p0[qq][15])};
            pw[qq][2] = (u32x4){cvtpk(p1[qq][0], p1[qq][1]), cvtpk(p1[qq][2], p1[qq][3]), cvtpk(p1[qq][4], p1[qq][5]), cvtpk(p1[qq][6], p1[qq][7])};
            pw[qq][3] = (u32x4){cvtpk(p1[qq][8], p1[qq][9]), cvtpk(p1[qq][10], p1[qq][11]), cvtpk(p1[qq][12], p1[qq][13]), cvtpk(p1[qq][14], p1[qq][15])};
        }
        const LAS unsigned char* vb = ring + LDS_V + t * 8192 + ((lane >> 4) & 1) * 32 + (lane & 3) * 8 + (4 * hi + ((lane & 15) >> 2)) * 64;
#pragma unroll
        for (int ks = 0; ks < 4; ++ks) {
            const s16x4 l0 = vtr(vb + ks * 1024), h0 = vtr(vb + ks * 1024 + 512), l1 = vtr(vb + 4096 + ks * 1024), h1 = vtr(vb + 4096 + ks * 1024 + 512);
            const bf16x8 v0 = (bf16x8){l0[0], l0[1], l0[2], l0[3], h0[0], h0[1], h0[2], h0[3]}, v1 = (bf16x8){l1[0], l1[1], l1[2], l1[3], h1[0], h1[1], h1[2], h1[3]};
#pragma unroll
            for (int qq = 0; qq < 2; ++qq) { const bf16x8 pa = __builtin_bit_cast(bf16x8, pw[qq][ks]);
                o0[qq] = __builtin_amdgcn_mfma_f32_32x32x16_bf16(pa, v0, o0[qq], 0, 0, 0); o1[qq] = __builtin_amdgcn_mfma_f32_32x32x16_bf16(pa, v1, o1[qq], 0, 0, 0); }
        }
    }
#pragma unroll
    for (int qq = 0; qq < 2; ++qq) {
        const int q0 = q0b + 32 * qq;
        const float lt = l_run[qq] + __shfl_xor(l_run[qq], 32);
        if (hi == 0) wsf[64 + 32 * qq + r32] = lt;
        asm volatile("s_waitcnt lgkmcnt(0)" ::: "memory");
        LAS unsigned short* stg = (LAS unsigned short*)(ring + LDS_OST + wid * 4096);
#pragma unroll
        for (int r = 0; r < 16; ++r) { const int orow = crow(r, hi); const float rli = __builtin_amdgcn_rcpf(wsf[64 + 32 * qq + orow]);
            stg[orow * 64 + r32] = f2bf(o0[qq][r] * rli); stg[orow * 64 + 32 + r32] = f2bf(o1[qq][r] * rli); }
        asm volatile("s_waitcnt lgkmcnt(0)" ::: "memory");
#pragma unroll
        for (int i = 0; i < 4; ++i) { const int row = i * 8 + (lane >> 3), ch = lane & 7; const u32x4 v = *(const LAS u32x4*)(stg + row * 64 + ch * 8);
            st16(AOPQ + (rowb + 128 * n + q0 + row) * KAB + h * 64 + ch * 8, v); }
        asm volatile("s_waitcnt lgkmcnt(0)" ::: "memory");
    }
}
}

constexpr size_t MiB = 1u << 20;
constexpr size_t WS_CTL = 0, CTL_ZERO_BYTES = 64 * 1024;
constexpr size_t WS_RS = 256 * 1024;
constexpr size_t RS_BYTES = (size_t)MTOK * 4 * 4;
constexpr size_t WS_WUP1 = 2 * MiB;
constexpr size_t WS_WDN1 = WS_WUP1 + 11 * MiB;
constexpr size_t WS_WIN = WS_WDN1 + 11 * MiB / 2;
constexpr size_t WS_WAB = WS_WIN + 13 * MiB / 2;
constexpr size_t WS_WO = WS_WAB + 3 * MiB;
constexpr size_t WS_WUP2 = WS_WO + 2 * MiB;
constexpr size_t WS_WDN2 = WS_WUP2 + 11 * MiB;
constexpr size_t WS_TM = WS_WDN2 + 11 * MiB / 2;
constexpr size_t WS_SLAB0 = WS_TM + 16 * MiB;
constexpr size_t WS_XB = WS_SLAB0, WS_AFF = WS_SLAB0 + 4 * MiB, WS_QKV = WS_SLAB0 + 4 * MiB, WS_FT = WS_SLAB0 + 7 * MiB, WS_GATES = WS_SLAB0 + 9 * MiB, WS_AOPQ = WS_SLAB0 + 17 * MiB;
constexpr size_t WS_END = WS_SLAB0 + 8 * SLAB;
static_assert(WS_END <= 256 * MiB && WS_RS + 4 * RS_BYTES <= WS_WUP1, "d_ws map");
static_assert((size_t)SEQ * DM * 2 == 4 * MiB && (size_t)SEQ * DFF * 2 == 11 * MiB && (size_t)SEQ * 768 * 2 == 3 * MiB && (size_t)512 * SEQ * 2 == 2 * MiB && (size_t)SEQ * 2048 * 2 == 8 * MiB && (size_t)SEQ * KAB * 2 == 6 * MiB, "slab pieces");

constexpr int RING_BYTES = 131072, LDSCTL_OFF = RING_BYTES, MISC_OFF = LDSCTL_OFF + 320, BIAS_OFF = LDSCTL_OFF + 512, WSF_OFF = BIAS_OFF + 4 * 512 * 4, LDS_BYTES = 147456;
static_assert(WSF_OFF + 8 * 128 * 4 <= LDS_BYTES, "LDS map");

#define XB_TMO      128
#define XB_XCNT(j)  (256  + 64 * (j))
#define XB_XSUB(j)  (1280 + 64 * (j))
#define XB_XGEN(j)  (2304 + 64 * (j))
#define XB_TOP      3328
#define XB_TOPGEN   3392
#define XCD_BAR_WORDS 3456
#define XB_SPIN_CAP (1u << 18)
__device__ __forceinline__ unsigned xb_ld(unsigned* p)              { return __hip_atomic_load(p, __ATOMIC_RELAXED, __HIP_MEMORY_SCOPE_AGENT); }
__device__ __forceinline__ unsigned xb_add(unsigned* p, unsigned v) { return __hip_atomic_fetch_add(p, v, __ATOMIC_RELAXED, __HIP_MEMORY_SCOPE_AGENT); }
__device__ __forceinline__ unsigned xb_xcc_id() { return (unsigned)__builtin_amdgcn_s_getreg((3 << 11) | 20) & 0xFu; }
#define XB_SPIN(cond, bar) do { unsigned _sp = 0; while (cond) { __builtin_amdgcn_s_sleep(1); \
    if ((++_sp & 255u) == 0u) { if (xb_ld(&(bar)[XB_TMO])) break; if (_sp > XB_SPIN_CAP) { atomicAdd(&(bar)[XB_TMO], 1u); break; } } } } while (0)
struct XcdBarrier { unsigned* bar; unsigned x; volatile LAS unsigned* st; };
__device__ __forceinline__ XcdBarrier xcd_barrier_post(unsigned* bar, volatile LAS unsigned* st) {
    XcdBarrier b; b.bar = bar; b.x = xb_xcc_id(); b.st = st;
    if (threadIdx.x == 0) (void)xb_add(&bar[XB_XCNT(b.x)], 1u);
    return b;
}
__device__ __forceinline__ void xcd_barrier_complete(unsigned* bar, unsigned x, unsigned& nloc, unsigned& nx) {
    const unsigned G = gridDim.x * gridDim.y * gridDim.z;
    unsigned sum, cnt, mine, sp = 0u;
    for (;;) {
        sum = 0u; cnt = 0u; mine = 0u;
#pragma unroll
        for (unsigned j = 0; j < 16; ++j) { const unsigned c = xb_ld(&bar[XB_XCNT(j)]); sum += c; cnt += (c > 0u) ? 1u : 0u; mine = (j == x) ? c : mine; }
        if (sum == G) break;
        __builtin_amdgcn_s_sleep(1);
        if ((++sp & 255u) == 0u) { if (xb_ld(&bar[XB_TMO])) break; if (sp > XB_SPIN_CAP) { atomicAdd(&bar[XB_TMO], 1u); break; } }
    }
    nloc = mine > 0u ? mine : 1u; nx = cnt > 0u ? cnt : 1u;
}
__device__ __forceinline__ void xcd_barrier(const XcdBarrier& b) {
    asm volatile("s_waitcnt vmcnt(0)" ::: "memory");
    __syncthreads();
    if (threadIdx.x == 0) {
        unsigned* bar = b.bar;
        __builtin_amdgcn_s_waitcnt(0);
        unsigned nloc = b.st[0], nx = b.st[1];
        if (nloc == 0u) { xcd_barrier_complete(bar, b.x, nloc, nx); b.st[0] = nloc; b.st[1] = nx; }
        const unsigned old = xb_add(&bar[XB_XSUB(b.x)], 1u);
        const unsigned gen = old / nloc;
        if (old + 1u == (gen + 1u) * nloc) {
            __builtin_amdgcn_fence(__ATOMIC_RELEASE, "agent");
            asm volatile("s_waitcnt vmcnt(0)" ::: "memory");
            const unsigned og = xb_add(&bar[XB_TOP], 1u);
            const unsigned tg = og / nx;
            if (og + 1u == (tg + 1u) * nx) xb_add(&bar[XB_TOPGEN], 1u);
            else XB_SPIN(xb_ld(&bar[XB_TOPGEN]) == tg, bar);
            __builtin_amdgcn_fence(__ATOMIC_ACQUIRE, "agent");
            xb_add(&bar[XB_XGEN(b.x)], 1u);
            asm volatile("s_waitcnt vmcnt(0)" ::: "memory");
        } else {
            XB_SPIN(xb_ld(&bar[XB_XGEN(b.x)]) == gen, bar);
            __builtin_amdgcn_fence(__ATOMIC_ACQUIRE, "agent");
            asm volatile("s_waitcnt vmcnt(0)" ::: "memory");
        }
    }
    __syncthreads();
}


__device__ __forceinline__ void group_barrier(unsigned* cnt, unsigned target, bool pure, unsigned* tmo) {
    asm volatile("s_waitcnt vmcnt(0)" ::: "memory");
    __syncthreads();
    if (threadIdx.x == 0) {
        if (!pure) { __builtin_amdgcn_fence(__ATOMIC_RELEASE, "agent"); asm volatile("s_waitcnt vmcnt(0)" ::: "memory"); }
        (void)xb_add(cnt, 1u);
        unsigned sp = 0u;
        while (xb_ld(cnt) < target) { __builtin_amdgcn_s_sleep(1); if ((++sp & 255u) == 0u) { if (xb_ld(tmo)) break; if (sp > XB_SPIN_CAP) { atomicAdd(tmo, 1u); break; } } }
        __builtin_amdgcn_fence(__ATOMIC_ACQUIRE, "agent");
        asm volatile("s_waitcnt vmcnt(0)" ::: "memory");
    }
    __syncthreads();
}


struct EpiFinal {
    static constexpr bool AFTER_DRAIN = true; static constexpr int MID_T = -1;
    const bf16_t* XB; float* out; float* RSo; const float* gfin; float alpha; unsigned* cnt; unsigned target; bool pure; unsigned* tmo;
    __device__ __forceinline__ void mid(Acc&, const Unit&, int, int, int, int) const {}
    __device__ __forceinline__ void operator()(const Acc&, const Unit&, int, int, int, int) const {}
    __device__ __forceinline__ void fused(Acc& acc, const Unit& u, int wr, int wc, int fr, int fq, LAS unsigned char* lds, int wid, int lane) const {
        asm volatile("" : "+v"(fr), "+v"(fq));
        LAS float* P = (LAS float*)lds;
#pragma unroll
        for (int ai = 0; ai < 2; ++ai) {
            u32x4 xr[4][2];
#pragma unroll
            for (int m = 0; m < 4; ++m)
#pragma unroll
                for (int bj = 0; bj < 2; ++bj) xr[m][bj] = *(const u32x4*)(brow(XB, u.pm * 256 + ai * 128 + wr * 64 + m * 16 + fr, DM) + u.pn * 256 + bj * 128 + wc * 32 + 8 * fq);
#pragma unroll
            for (int m = 0; m < 4; ++m) {
                const int rl = ai * 128 + wr * 64 + m * 16 + fr, row = u.pm * 256 + rl; float ss = 0.f;
#pragma unroll
                for (int bj = 0; bj < 2; ++bj) {
                    f32x4 x0, x1; unpack8(xr[m][bj], x0, x1);
                    x0 = x0 + acc[ai][bj][m][0] * alpha; x1 = x1 + acc[ai][bj][m][1] * alpha;
                    acc[ai][bj][m][0] = x0; acc[ai][bj][m][1] = x1;
                    ss += (x0[0] * x0[0] + x0[1] * x0[1]) + (x0[2] * x0[2] + x0[3] * x0[3]) + (x1[0] * x1[0] + x1[1] * x1[1]) + (x1[2] * x1[2] + x1[3] * x1[3]);
                }
                ss += __shfl_xor(ss, 16); ss += __shfl_xor(ss, 32);
                if (fq == 0) P[rl * 4 + wc] = ss;
            }
        }
        asm volatile("s_waitcnt lgkmcnt(0)" ::: "memory"); __builtin_amdgcn_s_barrier(); asm volatile("" ::: "memory");
        const int tid = wid * 64 + lane;
        if (tid < 256) { const f32x4 p = *(const LAS f32x4*)(P + tid * 4); RSo[(size_t)(u.pm * 256 + tid) * 4 + u.pn] = (p[0] + p[1]) + (p[2] + p[3]); }
        group_barrier(cnt, target, pure, tmo);
        asm volatile("" : "+v"(fr), "+v"(fq));
        f32x4 gv[2][2];
#pragma unroll
        for (int bj = 0; bj < 2; ++bj)
#pragma unroll
            for (int n = 0; n < 2; ++n) gv[bj][n] = *(const f32x4*)(gfin + u.pn * 256 + bj * 128 + wc * 32 + 8 * fq + 4 * n);
        float rv[2][4];
#pragma unroll
        for (int ai = 0; ai < 2; ++ai)
#pragma unroll
            for (int m = 0; m < 4; ++m) rv[ai][m] = row_rinv(RSo, u.pm * 256 + ai * 128 + wr * 64 + m * 16 + fr);
#pragma unroll
        for (int ai = 0; ai < 2; ++ai)
#pragma unroll
            for (int m = 0; m < 4; ++m) {
                const int row = u.pm * 256 + ai * 128 + wr * 64 + m * 16 + fr; const float r = rv[ai][m];
#pragma unroll
                for (int bj = 0; bj < 2; ++bj) { const size_t off = (size_t)row * DM + u.pn * 256 + bj * 128 + wc * 32 + 8 * fq;
                    st16f(out + off, acc[ai][bj][m][0] * gv[bj][0] * r); st16f(out + off + 4, acc[ai][bj][m][1] * gv[bj][1] * r); }
            }
    }
};

__device__ __forceinline__ float wave_sum(float v) {
#pragma unroll
    for (int o = 1; o < 64; o <<= 1) v += __shfl_xor(v, o);
    return v;
}
__device__ __forceinline__ int map_up(int rho) { const int pn = rho >> 8, i = rho & 255; return i < 128 ? 128 * pn + i : DFF + 128 * pn + (i - 128); }
__device__ __forceinline__ int map_in(int rho) { if (rho < 1280) return rho; const int t = (rho - 1280) >> 8, i = (rho - 1280) & 255; return i < 128 ? 1280 + 128 * t + i : 2304 + 128 * t + (i - 128); }

struct Args { const float* in[16]; float* out; unsigned char* ws; };

__global__ void __launch_bounds__(512, 2) mega_fwd(Args args) {
    extern __shared__ __attribute__((aligned(16))) unsigned char lds_raw[];
    LAS unsigned char* lds = (LAS unsigned char*)lds_raw;
    volatile LAS unsigned* MISC = (volatile LAS unsigned*)(lds + MISC_OFF);
    const int tid = threadIdx.x, lane = tid & 63, wave = __builtin_amdgcn_readfirstlane(tid >> 6);
    const int G = gridDim.x, bx = blockIdx.x;
    const int vcu = (G % 8 == 0) ? (bx % 8) * (G / 8) + bx / 8 : bx;
    unsigned char* ws = args.ws;
    unsigned* ctl = (unsigned*)(ws + WS_CTL);
    const float* x = args.in[0]; const float* g_ffn1 = args.in[1]; const float* w_up1 = args.in[2]; const float* w_dn1 = args.in[3]; const float* g_mix = args.in[4]; const float* w_in = args.in[5];
    const float* b_gate = args.in[6]; const float* sink = args.in[7]; const float* rel_bias = args.in[8]; const float* w_a = args.in[9]; const float* w_b = args.in[10]; const float* w_o = args.in[11];
    const float* g_ffn2 = args.in[12]; const float* w_up2 = args.in[13]; const float* w_dn2 = args.in[14]; const float* g_final = args.in[15];
    float* out = args.out;
    bf16_t* Wup1 = (bf16_t*)(ws + WS_WUP1); bf16_t* Wdn1 = (bf16_t*)(ws + WS_WDN1); bf16_t* Win = (bf16_t*)(ws + WS_WIN); bf16_t* Wab = (bf16_t*)(ws + WS_WAB); bf16_t* Wo = (bf16_t*)(ws + WS_WO);
    bf16_t* Wup2 = (bf16_t*)(ws + WS_WUP2); bf16_t* Wdn2 = (bf16_t*)(ws + WS_WDN2); bf16_t* Tm = (bf16_t*)(ws + WS_TM); bf16_t* XB = (bf16_t*)(ws + WS_XB);
    bf16_t* AFF = (bf16_t*)(ws + WS_AFF); bf16_t* QKV = (bf16_t*)(ws + WS_QKV); bf16_t* FT = (bf16_t*)(ws + WS_FT); bf16_t* GATES = (bf16_t*)(ws + WS_GATES); bf16_t* AOPQ = (bf16_t*)(ws + WS_AOPQ);
    float* RS0 = (float*)(ws + WS_RS); float* RS1 = (float*)(ws + WS_RS + RS_BYTES); float* RS2 = (float*)(ws + WS_RS + 2 * RS_BYTES); float* RS3 = (float*)(ws + WS_RS + 3 * RS_BYTES);

    for (int u = tid; u < (LDS_BYTES - LDSCTL_OFF) / 4; u += 512) ((LAS unsigned*)(lds + LDSCTL_OFF))[u] = 0u;
    __syncthreads();
    if (PROBE_K >= 0 && bx == 0 && tid == 0) { const unsigned long long t_ = __builtin_amdgcn_s_memrealtime(); MISC[18] = (unsigned)t_; MISC[19] = (unsigned)(t_ >> 32); }
    XcdBarrier bar = xcd_barrier_post(ctl + 1024, MISC + 8);
    unsigned* grp_cnt = ctl + 8192 + 64 * (bx & 7); unsigned* grp_census = ctl + 6144 + 16 * (bx & 7); unsigned grp_gen = 0u; bool grp_pure = false;
    if (tid == 0) (void)xb_add(grp_census + (bar.x & 15u), 1u);
#define GRID_BAR() xcd_barrier(bar)
#define STAMP(k) do { if ((k) == PROBE_K && bx == 0 && tid == 0) { const unsigned long long t_ = __builtin_amdgcn_s_memrealtime(); MISC[16] = (unsigned)t_; MISC[17] = (unsigned)(t_ >> 32); } } while (0)
#define GROUP_BAR() do { ++grp_gen; group_barrier(grp_cnt, grp_gen * (unsigned)(G / 8), grp_pure, ctl + 1024 + XB_TMO); } while (0)
#ifndef REPEAT
#define REPEAT -1
#endif
#ifndef NREP
#define NREP 2
#endif
#define PH(n) for (int rep_ = 0; rep_ < ((n) == REPEAT ? NREP : 1); ++rep_)

    constexpr int I_UP = 16 * (NUP / 32), I_DN = (DFF / 64) * (DM / 32), I_IN = 16 * (INW / 32), I_A = 8 * 32, I_O = 16 * 32;
    constexpr int NITEMS = 2 * I_UP + 2 * I_DN + I_IN + I_A + I_O;
    LAS float* cosT = (LAS float*)(lds + 8 * 8448);
    auto p0_transposes = [&](const int IT0, const int IT1, const int GW_, const int NGW_) {
        {
            LAS float* scr = (LAS float*)(lds + wave * 8448);
            const int kr = lane >> 3, c4 = lane & 7;
            struct TI { const float* src; const float* gk; bf16_t* dst; int ldsrc, ldd, k0; float cs; };
            auto decode = [&](int it, TI& t) {
                int r = it;
                if (r < 2 * I_UP) { const int second = r >= I_UP; if (second) r -= I_UP; const int nb = r % (NUP / 32), kb = r / (NUP / 32);
                    t.src = (second ? w_up2 : w_up1) + map_up(32 * nb); t.ldsrc = NUP; t.gk = second ? g_ffn2 : g_ffn1; t.cs = 1.0f; t.dst = (second ? Wup2 : Wup1) + (size_t)(32 * nb) * DM; t.ldd = DM; t.k0 = 64 * kb; return; }
                r -= 2 * I_UP;
                if (r < 2 * I_DN) { const int second = r >= I_DN; if (second) r -= I_DN; const int nb = r % 32, kb = r / 32;
                    t.src = (second ? w_dn2 : w_dn1) + 32 * nb; t.ldsrc = DM; t.gk = nullptr; t.cs = 1.0f; t.dst = (second ? Wdn2 : Wdn1) + (size_t)(32 * nb) * DFF; t.ldd = DFF; t.k0 = 64 * kb; return; }
                r -= 2 * I_DN;
                if (r < I_IN) { const int nb = r % (INW / 32), kb = r / (INW / 32);
                    t.src = w_in + map_in(32 * nb); t.ldsrc = INW; t.gk = g_mix; t.cs = (32 * nb < 512) ? QSCALE : 1.0f; t.dst = Win + (size_t)(32 * nb) * DM; t.ldd = DM; t.k0 = 64 * kb; return; }
                r -= I_IN;
                if (r < I_A) { const int nb = r % 32, kb = r / 32; t.src = w_a + 32 * nb; t.ldsrc = DM; t.gk = nullptr; t.cs = 1.0f; t.dst = Wab + (size_t)(32 * nb) * KAB; t.ldd = KAB; t.k0 = 64 * kb; return; }
                r -= I_A;
                { const int nb = r % 32, kb = r / 32; t.src = w_o + 32 * nb; t.ldsrc = DM; t.gk = nullptr; t.cs = 1.0f; t.dst = Wo + (size_t)(32 * nb) * DM; t.ldd = DM; t.k0 = 64 * kb; }
            };
            f32x4 cur[8], nxt[8]; float gc[8], gn[8];
            TI tc, tn;
            int it = IT0 + GW_;
            if (it < IT1) { decode(it, tc);
#pragma unroll
                for (int i = 0; i < 8; ++i) { const int k = tc.k0 + 8 * i + kr; cur[i] = *(const f32x4*)(tc.src + (size_t)k * tc.ldsrc + 4 * c4); gc[i] = tc.gk ? tc.gk[k] : 1.0f; } }
            while (it < IT1) {
                const int itn = it + NGW_; const bool hn = itn < IT1;
                if (hn) { decode(itn, tn);
#pragma unroll
                    for (int i = 0; i < 8; ++i) { const int k = tn.k0 + 8 * i + kr; nxt[i] = *(const f32x4*)(tn.src + (size_t)k * tn.ldsrc + 4 * c4); gn[i] = tn.gk ? tn.gk[k] : 1.0f; } }
#pragma unroll
                for (int i = 0; i < 8; ++i) { const float sc = gc[i] * tc.cs; LAS float* p = scr + (8 * i + kr) * 33 + 4 * c4; p[0] = cur[i][0] * sc; p[1] = cur[i][1] * sc; p[2] = cur[i][2] * sc; p[3] = cur[i][3] * sc; }
                asm volatile("s_waitcnt lgkmcnt(0)" ::: "memory");
                { const int c = lane & 7;
#pragma unroll
                  for (int j = 0; j < 4; ++j) { const int n = (lane >> 3) + 8 * j; const LAS float* s = scr + (8 * c) * 33 + n;
                      u32x4 o; o.x = cvtpk(s[0 * 33], s[1 * 33]); o.y = cvtpk(s[2 * 33], s[3 * 33]); o.z = cvtpk(s[4 * 33], s[5 * 33]); o.w = cvtpk(s[6 * 33], s[7 * 33]);
                      st16(tc.dst + (size_t)n * tc.ldd + tc.k0 + 8 * c, o); } }
                asm volatile("s_waitcnt lgkmcnt(0)" ::: "memory");
                if (hn) { tc = tn;
#pragma unroll
                    for (int i = 0; i < 8; ++i) { cur[i] = nxt[i]; gc[i] = gn[i]; } }
                it = itn;
            }
        }
    };
    auto p0_xb = [&](const int GW_, const int NGW_) {
        {
            f32x4 v[4], w[4]; int m = GW_;
            if (m < MTOK) { const f32x4* xr = (const f32x4*)(x + (size_t)m * DM) + 2 * lane;
#pragma unroll
                for (int j = 0; j < 2; ++j) { v[2 * j] = xr[128 * j]; v[2 * j + 1] = xr[128 * j + 1]; } }
            while (m < MTOK) {
                const int mn = m + NGW_;
                if (mn < MTOK) { const f32x4* xr = (const f32x4*)(x + (size_t)mn * DM) + 2 * lane;
#pragma unroll
                    for (int j = 0; j < 2; ++j) { w[2 * j] = xr[128 * j]; w[2 * j + 1] = xr[128 * j + 1]; } }
                float s = 0.f;
#pragma unroll
                for (int j = 0; j < 4; ++j) s += (v[j][0] * v[j][0] + v[j][1] * v[j][1]) + (v[j][2] * v[j][2] + v[j][3] * v[j][3]);
                s = wave_sum(s);
#pragma unroll
                for (int j = 0; j < 2; ++j) st16(brow(XB, m, DM) + 512 * j + 8 * lane, pack8(v[2 * j], v[2 * j + 1]));
                if (lane == 0) *(f32x4*)(RS0 + (size_t)m * 4) = (f32x4){s, 0.f, 0.f, 0.f};
#pragma unroll
                for (int j = 0; j < 4; ++j) v[j] = w[j];
                m = mn;
            }
        }
    };
    auto p0_fold_tm = [&](const int GW_, const int NGW_) {
        {
            LAS float* tab = (LAS float*)(lds + 8 * 8448 + 8192 + wave * 4096);
            for (int item = GW_; item < 2048; item += NGW_) {
                const int kg = item >> 4, ng = item & 15, g = kg >> 5, j0 = (8 * kg) & 255, part = j0 >> 7, c0 = j0 & 127, n = 64 * ng + lane;
#pragma unroll
                for (int i = 0; i < 16; ++i) { const int idx = lane + 64 * i, cp = idx >> 3, e = idx & 7, ph = ((c0 + e) * cp) & 127; tab[idx] = part ? -cosT[(16 * ph - 512) & 2047] : cosT[16 * ph]; }
                asm volatile("s_waitcnt lgkmcnt(0)" ::: "memory");
                float a8[8];
#pragma unroll
                for (int e = 0; e < 8; ++e) a8[e] = 0.f;
                const float* wp = w_b + (size_t)(g * 128) * DM + n;
                float wa[64], wb[64];
#pragma unroll
                for (int i = 0; i < 64; ++i) wa[i] = wp[(size_t)i * DM];
#pragma unroll
                for (int i = 0; i < 64; ++i) wb[i] = wp[(size_t)(64 + i) * DM];
#pragma unroll
                for (int i = 0; i < 64; ++i) { const int cp = i; const float w = wa[i]; const f32x4 t0 = *(const LAS f32x4*)(tab + cp * 8), t1 = *(const LAS f32x4*)(tab + cp * 8 + 4);
                    a8[0] += w * t0[0]; a8[1] += w * t0[1]; a8[2] += w * t0[2]; a8[3] += w * t0[3]; a8[4] += w * t1[0]; a8[5] += w * t1[1]; a8[6] += w * t1[2]; a8[7] += w * t1[3];
                    if ((i & 3) == 3) asm volatile("" : "+v"(a8[0]), "+v"(a8[1]), "+v"(a8[2]), "+v"(a8[3]), "+v"(a8[4]), "+v"(a8[5]), "+v"(a8[6]), "+v"(a8[7])); }
#pragma unroll
                for (int i = 0; i < 64; ++i) { const int cp = 64 + i; const float w = wb[i]; const f32x4 t0 = *(const LAS f32x4*)(tab + cp * 8), t1 = *(const LAS f32x4*)(tab + cp * 8 + 4);
                    a8[0] += w * t0[0]; a8[1] += w * t0[1]; a8[2] += w * t0[2]; a8[3] += w * t0[3]; a8[4] += w * t1[0]; a8[5] += w * t1[1]; a8[6] += w * t1[2]; a8[7] += w * t1[3];
                    if ((i & 3) == 3) asm volatile("" : "+v"(a8[0]), "+v"(a8[1]), "+v"(a8[2]), "+v"(a8[3]), "+v"(a8[4]), "+v"(a8[5]), "+v"(a8[6]), "+v"(a8[7])); }
                const float sc = 0.08838834764831845f;
                u32x4 o; o.x = cvtpk(a8[0] * sc, a8[1] * sc); o.y = cvtpk(a8[2] * sc, a8[3] * sc); o.z = cvtpk(a8[4] * sc, a8[5] * sc); o.w = cvtpk(a8[6] * sc, a8[7] * sc);
                st16(Wab + (size_t)n * KAB + 512 + 8 * kg, o);
                asm volatile("s_waitcnt lgkmcnt(0)" ::: "memory");
            }
        }
    };
    auto p0_tm = [&](const int GW_, const int NGW_) {
        for (int idx = GW_ * 64 + lane; idx < 2048 * 256; idx += NGW_ * 64) {
            const int rT = idx >> 8, s0 = (idx & 255) * 8, part = rT >> 10, k = (rT == 1024) ? 1024 : (rT & 1023); const float sc = 0.022097086912079608f;
            float v[8];
#pragma unroll
            for (int e = 0; e < 8; ++e) { const int ph = (k * (s0 + e)) & 2047; v[e] = cosT[(part && rT != 1024) ? ((ph - 512) & 2047) : ph] * sc; }
            u32x4 o; o.x = cvtpk(v[0], v[1]); o.y = cvtpk(v[2], v[3]); o.z = cvtpk(v[4], v[5]); o.w = cvtpk(v[6], v[7]);
            st16(Tm + (size_t)rT * SEQ + s0, o);
        }
    };
    PH(0) {
        const int gw = vcu * 8 + wave, NGW = G * 8;
        for (int j = tid; j < 2048; j += 512) cosT[j] = cospif((float)j * (1.0f / 1024.0f));
        __syncthreads();
        if (wave & 1) p0_fold_tm(gw, NGW);
        p0_xb(gw, NGW);
        p0_transposes(0, I_UP, gw, NGW);
        if (!(wave & 1)) p0_fold_tm(gw, NGW);
        __syncthreads();
    }
    GRID_BAR(); STAMP(1);
    grp_pure = (G % 8 == 0) && (xb_ld(grp_census + (bar.x & 15u)) == (unsigned)(G / 8));

    PH(1) { SchedPlain S; S.T.init(MTOK, NUP, G, bx); S.A = (const char*)XB; S.Bt = (const char*)Wup1; S.tA = (size_t)256 * DM * 2; S.tB = (size_t)256 * DM * 2;
      EpiSwiGLU E{RS0, AFF}; pg8::gemm_phase<EpiSwiGLU, SchedPlain, true>(lds, pg8::GemmP{DM, DM, DM}, S, E); }
    if (2 * bx >= G) {
        const int gw = (bx - G / 2) * 8 + wave, NGW = (G - G / 2) * 8;
        for (int j = tid; j < 2048; j += 512) cosT[j] = cospif((float)j * (1.0f / 1024.0f));
        __syncthreads();
        p0_transposes(I_UP, NITEMS, gw, NGW);
        p0_tm(gw, NGW);
        __syncthreads();
    }
    GRID_BAR(); STAMP(2);
    PH(2) { SchedPlain S; S.T.init(MTOK, DM, G, bx); S.A = (const char*)AFF; S.Bt = (const char*)Wdn1; S.tA = (size_t)256 * DFF * 2; S.tB = (size_t)256 * DFF * 2;
      EpiResid<true> E{x, XB, RS1, 0.5f}; pg8::gemm_phase<EpiResid<true>, SchedPlain, false>(lds, pg8::GemmP{DFF, DFF, DFF}, S, E); }
    GROUP_BAR(); STAMP(3);
    PH(3) { SchedWin S; S.T.init(MTOK, 12 * 256, G, bx); S.X = (const char*)XB; S.W = (const char*)Win; S.tX = (size_t)256 * DM * 2; S.tW = (size_t)256 * DM * 2;
      EpiWin E{RS1, b_gate, QKV, FT, GATES}; pg8::gemm_phase<EpiWin, SchedWin, true>(lds, pg8::GemmP{DM, DM, DM}, S, E); }
    GROUP_BAR(); STAMP(4);
    { const int b = bx & 7, ci = bx >> 3;
      if (ci < 16) {
        PH(41) { SchedOne S; S.u0 = Unit{ci >> 1, ci & 1}; S.A = (const char*)(Tm + (size_t)(ci >> 1) * 256 * SEQ); S.Bt = (const char*)(FT + (size_t)b * SLAB_E + (size_t)(ci & 1) * 256 * SEQ);
          EpiDft E{AOPQ, b}; pg8::gemm_phase<EpiDft, SchedOne, false>(lds, pg8::GemmP{SEQ, SEQ, SEQ}, S, E); }
      } else {
        if (ci < 24) { SchedOne S; S.u0 = Unit{8 * b + (ci - 16), 12}; S.A = (const char*)(brow(XB, (8 * b + (ci - 16)) * 256, DM)); S.Bt = (const char*)(Win + (size_t)12 * 256 * DM);
          EpiWin E{RS1, b_gate, QKV, FT, GATES}; pg8::gemm_phase<EpiWin, SchedOne, false>(lds, pg8::GemmP{DM, DM, DM}, S, E); }
        const int na = ci < 24 ? 1 : 3, a0 = ci < 24 ? ci - 16 : 8 + 3 * (ci - 24);
        PH(42) { for (int r = 0; r < na; ++r) { const int a = a0 + r;
            att::attn_unit(lds, (LAS float*)(lds + BIAS_OFF), (LAS float*)(lds + WSF_OFF), QKV, AOPQ, sink, rel_bias, b, a & 1, a >> 1);
            asm volatile("s_waitcnt lgkmcnt(0)" ::: "memory"); __builtin_amdgcn_s_barrier(); } }
      }
    }
    GROUP_BAR(); STAMP(5);
    PH(5) { SchedPlain S; S.T.init(MTOK, DM, G, bx); S.A = (const char*)AOPQ; S.Bt = (const char*)Wab; S.tA = (size_t)256 * KAB * 2; S.tB = (size_t)256 * KAB * 2;
      EpiGate E{GATES}; pg8::gemm_phase<EpiGate, SchedPlain, false>(lds, pg8::GemmP{KAB, KAB, KAB}, S, E); }
    GROUP_BAR(); STAMP(6);
    PH(6) { SchedPlain S; S.T.init(MTOK, DM, G, bx); S.A = (const char*)GATES; S.Bt = (const char*)Wo; S.tA = (size_t)256 * 2048 * 2; S.tB = (size_t)256 * DM * 2;
      EpiResid<false> E{nullptr, XB, RS2, 1.0f}; pg8::gemm_phase<EpiResid<false>, SchedPlain, false>(lds, pg8::GemmP{DM, 2048, DM}, S, E); }
    GROUP_BAR(); STAMP(7);
    PH(7) { SchedPlain S; S.T.init(MTOK, NUP, G, bx); S.A = (const char*)XB; S.Bt = (const char*)Wup2; S.tA = (size_t)256 * DM * 2; S.tB = (size_t)256 * DM * 2;
      EpiSwiGLU E{RS2, AFF}; pg8::gemm_phase<EpiSwiGLU, SchedPlain, true>(lds, pg8::GemmP{DM, DM, DM}, S, E); }
    GROUP_BAR(); STAMP(8);
    PH(8) { SchedPlain S; S.T.init(MTOK, DM, G, bx); S.A = (const char*)AFF; S.Bt = (const char*)Wdn2; S.tA = (size_t)256 * DFF * 2; S.tB = (size_t)256 * DFF * 2;
      ++grp_gen; EpiFinal E{XB, out, RS3, g_final, 0.5f, grp_cnt, grp_gen * (unsigned)(G / 8), grp_pure, ctl + 1024 + XB_TMO};
      pg8::gemm_phase<EpiFinal, SchedPlain, false>(lds, pg8::GemmP{DFF, DFF, DFF}, S, E); }
    if (PROBE_K >= 0 && bx == 0 && tid == 0) { const unsigned long long t_sel = ((unsigned long long)MISC[17] << 32) | MISC[16], t_start = ((unsigned long long)MISC[19] << 32) | MISC[18]; const unsigned long long t_end = __builtin_amdgcn_s_memrealtime(), want = 4ull * (t_sel - t_start); while (__builtin_amdgcn_s_memrealtime() - t_end < want) __builtin_amdgcn_s_sleep(8); }
}

extern "C" void kernel_launch(void* const* d_in, const int* in_sizes, int n_in, void* d_out, int out_size, void* d_ws, size_t ws_size, hipStream_t stream) {
    static int grid = 0;
    if (grid == 0) {
        if (n_in != 16 || in_sizes[0] != MTOK * DM || out_size != MTOK * DM || ws_size < WS_END) { fprintf(stderr, "kernel_launch: unexpected shapes (n_in %d, ws %zu)\n", n_in, ws_size); grid = -1; return; }
        int dev = 0, cus = 0, per_cu = 0;
        if (hipGetDevice(&dev) != hipSuccess || hipDeviceGetAttribute(&cus, hipDeviceAttributeMultiprocessorCount, dev) != hipSuccess) { grid = -1; return; }
        if (hipFuncSetAttribute((const void*)mega_fwd, hipFuncAttributeMaxDynamicSharedMemorySize, LDS_BYTES) != hipSuccess) { fprintf(stderr, "kernel_launch: hipFuncSetAttribute failed\n"); grid = -1; return; }
        if (hipOccupancyMaxActiveBlocksPerMultiprocessor(&per_cu, (const void*)mega_fwd, 512, LDS_BYTES) != hipSuccess || per_cu < 1) { fprintf(stderr, "kernel_launch: occupancy query says %d\n", per_cu); }
        (void)hipGetLastError();
        grid = cus;
        if (grid != 256) { fprintf(stderr, "kernel_launch: needs 256 CUs, device has %d\n", cus); grid = -1; return; }
    }
    if (grid < 0) return;
    if (hipMemsetAsync((char*)d_ws + WS_CTL, 0, CTL_ZERO_BYTES, stream) != hipSuccess) return;
    Args a{};
    for (int i = 0; i < 16; ++i) a.in[i] = (const float*)d_in[i];
    a.out = (float*)d_out; a.ws = (unsigned char*)d_ws;
    hipLaunchKernelGGL(mega_fwd, dim3(grid), dim3(512), LDS_BYTES, stream, a);
}
```
